# Optimizing an MI355X kernel written in HIP

```python
import jax, jax.numpy as jnp
from jax import lax
import numpy as np

D_MODEL = 1024
BATCH = 4
SEQ = 8192
DEPTH = 2

HGRN_HEADS = 8
HGRN_EXPAND = 128
HGRN_VDIM = 128
HGRN_KEY_WIDTH = HGRN_HEADS * HGRN_EXPAND
HGRN_VAL_WIDTH = HGRN_HEADS * HGRN_VDIM
HGRN_SCALE = HGRN_EXPAND ** -0.5
CHUNK = 64
F_MIN = 1e-6
CONV_CH = D_MODEL
CONV_K = 3
D_FF = 2816
N_EXPERTS = 8
TOP_K = 2
EPS = 1e-6
N_DENSE = (DEPTH + 1) // 2
N_MOE = DEPTH // 2
IN_SPLITS = (HGRN_KEY_WIDTH, HGRN_KEY_WIDTH, HGRN_VAL_WIDTH, HGRN_VAL_WIDTH,
             CONV_CH, CONV_CH, CONV_CH, D_MODEL, D_MODEL)
IN_WIDTH = sum(IN_SPLITS)

kernel_name = "hgrn2_shortconv_gated_merge_moe"


def rms_norm(x, w):
    xf = x.astype(jnp.float32)
    y = xf * lax.rsqrt(jnp.mean(xf * xf, axis=-1, keepdims=True) + EPS)
    return (y * w.astype(jnp.float32)).astype(x.dtype)


def split_projection(h, w):
    outs = []
    start = 0
    for width in IN_SPLITS:
        outs.append(jnp.einsum('bsd,de->bse', h, w[:, start:start + width]))
        start += width
    return outs


def hgrn2_chunk_recurrence(q, k, v, log_f):
    bsz, seq, nh, kd = q.shape
    vd = v.shape[-1]
    n_chunks = seq // CHUNK

    def to_chunks(t):
        return t.reshape(bsz, n_chunks, CHUNK, nh, t.shape[-1]).transpose(1, 0, 3, 2, 4)

    causal = jnp.tril(jnp.ones((CHUNK, CHUNK), dtype=bool))[:, :, None]

    def step(state, inp):
        qc, kc, vc, gc = inp
        cum = jnp.cumsum(gc, axis=2)
        diff = cum[:, :, :, None, :] - cum[:, :, None, :, :]
        decay = jnp.where(causal, jnp.exp(jnp.where(causal, diff, 0.0)), 0.0)
        scores = jnp.einsum('bhtk,bhtsk,bhsk->bhts', qc, decay, kc)
        o = (jnp.einsum('bhts,bhsv->bhtv', scores, vc)
             + jnp.einsum('bhtk,bhkv->bhtv', qc * jnp.exp(cum), state))
        last = cum[:, :, -1:, :]
        state = (jnp.exp(last[:, :, 0, :])[..., None] * state
                 + jnp.einsum('bhsk,bhsv->bhkv', kc * jnp.exp(last - cum), vc))
        return state, o

    s0 = jnp.zeros((bsz, nh, kd, vd), jnp.float32)
    _, o = lax.scan(step, s0, (to_chunks(q), to_chunks(k), to_chunks(v), to_chunks(log_f)))
    return o.transpose(1, 0, 3, 2, 4).reshape(bsz, seq, nh, vd)


def hybrid_mixer(h, w_in, lb, g_norm_w, conv_w, w_proj_hgrn, w_proj_conv, w_out):
    bsz, seq, _ = h.shape
    q, f_logit, i_in, g_out, b_gate, c_gate, u, gate_a, gate_b = split_projection(h, w_in)

    def heads(t):
        return t.reshape(bsz, seq, HGRN_HEADS, -1).astype(jnp.float32)

    z = heads(f_logit)
    lbh = lb.astype(jnp.float32).reshape(HGRN_HEADS, HGRN_EXPAND)
    f = lbh + (1.0 - lbh) * jax.nn.sigmoid(z)
    log_f = jnp.log(jnp.maximum(f, F_MIN))
    k = (1.0 - lbh) * jax.nn.sigmoid(-z)
    qh = jax.nn.silu(heads(q)) * HGRN_SCALE
    o = hgrn2_chunk_recurrence(qh, k, heads(i_in), log_f)
    o = rms_norm(o, g_norm_w) * jax.nn.silu(heads(g_out))
    y_a = jnp.einsum('bse,ed->bsd', o.reshape(bsz, seq, HGRN_VAL_WIDTH).astype(h.dtype), w_proj_hgrn)

    v = b_gate * u
    vp = jnp.pad(v, ((0, 0), (CONV_K - 1, 0), (0, 0)))
    conv = conv_w[0] * vp[:, 0:seq, :]
    for j in range(1, CONV_K):
        conv = conv + conv_w[j] * vp[:, j:j + seq, :]
    y_b = jnp.einsum('bse,ed->bsd', c_gate * conv, w_proj_conv)

    merged = jax.nn.sigmoid(gate_a) * y_a + jax.nn.sigmoid(gate_b) * y_b
    return jnp.einsum('bsd,de->bse', merged, w_out)


def swiglu(h, w1, w3, w2):
    a = jnp.einsum('bsd,df->bsf', h, w1)
    b = jnp.einsum('bsd,df->bsf', h, w3)
    return jnp.einsum('bsf,fd->bsd', jax.nn.silu(a) * b, w2)


def moe_swiglu(h, router_w, w1, w3, w2):
    bsz, seq, d = h.shape
    t = h.reshape(bsz * seq, d)
    logits = jnp.einsum('td,de->te', t, router_w).astype(jnp.float32)
    top_vals, top_idx = lax.top_k(logits, TOP_K)
    top_w = jax.nn.softmax(top_vals, axis=-1)
    gates = jnp.sum(jax.nn.one_hot(top_idx, N_EXPERTS, dtype=jnp.float32) * top_w[..., None], axis=1)
    gates = gates.astype(h.dtype)
    out = jnp.zeros_like(t)
    for e in range(N_EXPERTS):
        a = t @ w1[e]
        b = t @ w3[e]
        out = out + gates[:, e:e + 1] * ((jax.nn.silu(a) * b) @ w2[e])
    return out.reshape(bsz, seq, d)


def setup_inputs(seed: int = 0) -> dict:
    key = jax.random.key(seed)
    ks = jax.random.split(key, 20)
    nrm = lambda k, shape, fan_in: jax.random.normal(k, shape, jnp.float32) * (fan_in ** -0.5)
    gain = lambda k, shape: 1.0 + 0.05 * jax.random.normal(k, shape, jnp.float32)
    return {
        "x": jax.random.normal(ks[0], (BATCH, SEQ, D_MODEL), jnp.float32),
        "w_in": nrm(ks[1], (DEPTH, D_MODEL, IN_WIDTH), D_MODEL),
        "lower_bounds": 0.1 * jax.random.normal(ks[2], (DEPTH, HGRN_KEY_WIDTH), jnp.float32),
        "hgrn_norm_w": gain(ks[3], (DEPTH, HGRN_VDIM)),
        "conv_w": nrm(ks[4], (DEPTH, CONV_K, CONV_CH), CONV_K),
        "w_proj_hgrn": nrm(ks[5], (DEPTH, HGRN_VAL_WIDTH, D_MODEL), HGRN_VAL_WIDTH),
        "w_proj_conv": nrm(ks[6], (DEPTH, CONV_CH, D_MODEL), CONV_CH),
        "w_out": nrm(ks[7], (DEPTH, D_MODEL, D_MODEL), D_MODEL),
        "norm_mix": gain(ks[8], (DEPTH, D_MODEL)),
        "norm_ffn": gain(ks[9], (DEPTH, D_MODEL)),
        "dense_w1": nrm(ks[10], (N_DENSE, D_MODEL, D_FF), D_MODEL),
        "dense_w3": nrm(ks[11], (N_DENSE, D_MODEL, D_FF), D_MODEL),
        "dense_w2": nrm(ks[12], (N_DENSE, D_FF, D_MODEL), D_FF),
        "router_w": nrm(ks[13], (N_MOE, D_MODEL, N_EXPERTS), D_MODEL),
        "expert_w1": nrm(ks[14], (N_MOE, N_EXPERTS, D_MODEL, D_FF), D_MODEL),
        "expert_w3": nrm(ks[15], (N_MOE, N_EXPERTS, D_MODEL, D_FF), D_MODEL),
        "expert_w2": nrm(ks[16], (N_MOE, N_EXPERTS, D_FF, D_MODEL), D_FF),
        "final_norm": gain(ks[17], (D_MODEL,)),
    }


def reference(x, w_in, lower_bounds, hgrn_norm_w, conv_w, w_proj_hgrn, w_proj_conv, w_out,
              norm_mix, norm_ffn, dense_w1, dense_w3, dense_w2, router_w,
              expert_w1, expert_w3, expert_w2, final_norm):
    lb_soft = jax.nn.softmax(lower_bounds.astype(jnp.float32), axis=0)
    lb_all = jnp.cumsum(lb_soft, axis=0) - lb_soft[0]
    for layer in range(DEPTH):
        h = rms_norm(x, norm_mix[layer])
        x = x + hybrid_mixer(h, w_in[layer], lb_all[layer], hgrn_norm_w[layer], conv_w[layer],
                             w_proj_hgrn[layer], w_proj_conv[layer], w_out[layer])
        h = rms_norm(x, norm_ffn[layer])
        if layer % 2 == 0:
            j = layer // 2
            x = x + swiglu(h, dense_w1[j], dense_w3[j], dense_w2[j])
        else:
            j = layer // 2
            x = x + moe_swiglu(h, router_w[j], expert_w1[j], expert_w3[j], expert_w2[j])
    return rms_norm(x, final_norm)
```

```cpp
#include <hip/hip_runtime.h>
#include <cstdio>
#include <cstdint>

#ifndef MK_PER_PHASE
#define MK_PER_PHASE 0
#endif

#define LAS __attribute__((address_space(3)))
#define GAS __attribute__((address_space(1)))
typedef unsigned short bf16_t;
typedef short bf16x8 __attribute__((ext_vector_type(8)));
typedef float f32x4 __attribute__((ext_vector_type(4)));
typedef float f32x2 __attribute__((ext_vector_type(2)));
typedef unsigned u32x4 __attribute__((ext_vector_type(4)));
typedef unsigned u32x2 __attribute__((ext_vector_type(2)));
#define RLX_AGENT __ATOMIC_RELAXED, __HIP_MEMORY_SCOPE_AGENT

constexpr int D = 1024, BATCH = 4, SEQ = 8192, T = BATCH * SEQ, NH = 8, HK = 128, HV = 128;
constexpr int DFF = 2816, NE = 8, INW = 9216;
constexpr float EPS = 1e-6f, QSCALE = 0.08838834764831845f;
constexpr int NS = T + NE * 256;
constexpr int NSTILE = NS / 256;

constexpr size_t MiB = 1u << 20;
constexpr size_t WS_CTL = 0;
constexpr size_t ZERO_BYTES = 65536;
constexpr size_t OFF_SSQ = 65536;
constexpr size_t OFF_LB = OFF_SSQ + (size_t)4 * T * 16;
constexpr size_t OFF_BLKCNT = OFF_LB + 8192;
constexpr size_t OFF_META = OFF_BLKCNT + 16384;
constexpr size_t OFF_ROUTE = OFF_META + 4096;
constexpr size_t OFF_TOK = OFF_ROUTE + (size_t)T * 16;
constexpr size_t OFF_GATE = OFF_TOK + (size_t)2 * NS * 4;
constexpr size_t OFF_RSS = OFF_GATE + (size_t)2 * NS * 4;
static_assert(OFF_RSS + (size_t)2 * NS * 4 <= 4 * MiB, "ctl region");
constexpr size_t WS_XB = 4 * MiB;
constexpr size_t WS_P = 68 * MiB;
constexpr size_t WS_S = 324 * MiB;
constexpr size_t WS_WNE = 388 * MiB;
constexpr size_t WS_WE = 388 * MiB;
constexpr size_t WS_END = 520 * MiB;
constexpr size_t WN_INA = 0;
constexpr size_t WN_INB = WN_INA + (size_t)2 * 4096 * 1024;
constexpr size_t WN_PROJ = WN_INB + (size_t)2 * 5120 * 1024;
constexpr size_t WN_OUT = WN_PROJ + (size_t)2 * 1024 * 2048;
constexpr size_t WN_D13 = WN_OUT + (size_t)2 * 1024 * 1024;
constexpr size_t WN_D2 = WN_D13 + (size_t)5632 * 1024;
constexpr size_t WN_END = WN_D2 + (size_t)1024 * 2816;
static_assert(WN_END * 2 <= 65 * MiB, "wne");
constexpr size_t WE_13 = 0;
constexpr size_t WE_2 = (size_t)8 * 5632 * 1024;
static_assert((WE_2 + (size_t)8 * 1024 * 2816) * 2 <= WS_END - WS_WE, "we");
constexpr size_t WS_H = WS_P;
constexpr size_t WS_AG = WS_P + 188 * MiB;
static_assert((size_t)NS * 2816 * 2 <= 188 * MiB && WS_AG + (size_t)NS * 2048 <= WS_S + 64 * MiB, "moe map");

constexpr int CW_TMO = 0, CW_CODE = 1, CW_BAR = 4096;

constexpr int RING_BYTES = 131072;
constexpr int LDSCTL_OFF = RING_BYTES, MISC_OFF = LDSCTL_OFF + 320, RED_OFF = LDSCTL_OFF + 2048;
constexpr int LDS_BYTES = 147456;
constexpr int NWAVES = 8;

namespace pg8 {
constexpr int BM = 256, BK = 64, HALF = 128, HTB = HALF * BK * 2, STAGE_BYTES = 8 * HTB, NXCD = 8, WGM = 8;
__host__ __device__ __forceinline__ int lds_byte(int r, int c) { const int st = (r >> 4) * 2 + (c >> 5), rr = r & 15, cc = c & 31, ob = rr * 64 + cc * 2; return st * 1024 + (ob ^ (((ob >> 9) & 1) << 5)); }
__host__ __device__ __forceinline__ void stage_rc(int b, int& R, int& C) { const int st = b / 1024, sb = b % 1024, swz = sb ^ (((sb >> 9) & 1) << 5); R = (st >> 1) * 16 + swz / 64; C = (st & 1) * 32 + (swz % 64) / 2; }
__host__ __device__ __forceinline__ int perm32(int rho) { const int n = rho >> 4, i = rho & 15; return 8 * (i >> 2) + 4 * n + (i & 3); }

struct Unit { int pm, pn, e; };
struct Gemm { const bf16_t* A; const bf16_t* Bt; int lda; int K; int a_jump; size_t b_estride; };

struct StaticOrder {
    int nM, nN, nwg, G, c;
    __device__ void init(int nM_, int nN_, int G_, int c_) { nM = nM_; nN = nN_; nwg = nM * nN; G = G_; c = c_; }
    __device__ bool next(int i, Unit& u) const {
        const long L = (long)i * G + c; if (L >= nwg) return false;
        int wgid = (int)L; { const int q = nwg / NXCD, r = nwg % NXCD, xcd = wgid % NXCD, off = wgid / NXCD; wgid = (xcd < r ? xcd * (q + 1) : r * (q + 1) + (xcd - r) * q) + off; }
        const int nig = WGM * nN, gid = wgid / nig, fm = gid * WGM, gsz = (nM - fm) < WGM ? (nM - fm) : WGM;
        u.pm = fm + ((wgid % nig) % gsz); u.pn = (wgid % nig) / gsz; u.e = 0; return true;
    }
};
struct MoeOrder {
    StaticOrder so; const unsigned* tile_e;
    __device__ bool next(int i, Unit& u) const {
        if (!so.next(i, u)) return false;
        u.e = (int)__builtin_amdgcn_readfirstlane(__hip_atomic_load(tile_e + u.pm, RLX_AGENT)); return true;
    }
};

__device__ __forceinline__ unsigned cvt_pk_bf16(float lo, float hi) { unsigned r; asm volatile("v_cvt_pk_bf16_f32 %0, %1, %2" : "=v"(r) : "v"(lo), "v"(hi)); return r; }
__device__ __forceinline__ float bf_lo(unsigned w) { return __uint_as_float(w << 16); }
__device__ __forceinline__ float bf_hi(unsigned w) { return __uint_as_float(w & 0xffff0000u); }
__device__ __forceinline__ float sigmoidf_(float v) { return __builtin_amdgcn_rcpf(1.0f + __expf(-v)); }
__device__ __forceinline__ float siluf_(float v) { return v * sigmoidf_(v); }

typedef f32x4 Acc[2][2][4][2];

template <class Epi, class Sched>
__device__ __forceinline__ void gemm_phase(LAS unsigned char* lds, const Gemm g, const Sched& S, const Epi& E) {
    int tid_ = threadIdx.x; asm volatile("" : "+v"(tid_));
    const int tid = tid_, wid = __builtin_amdgcn_readfirstlane(tid >> 6), lane = tid & 63, wr = wid >> 2, wc = wid & 3, fr = lane & 15, fq = lane >> 4;
    const int K = g.K, nt = K / BK, th = nt / 2;
    unsigned voffA[2], voffB[2];
#pragma unroll
    for (int i = 0; i < 2; ++i) { int R, C; stage_rc(tid * 16 + i * 8192, R, C); const int Rb = (R & ~31) + perm32(R & 31);
        voffA[i] = (unsigned)(R * g.lda + C) * 2u; voffB[i] = (unsigned)(Rb * K + C) * 2u; }
    const size_t kstep = (size_t)(BK * 2);
    const size_t hstepA = (size_t)HALF * g.lda * 2, tstepA = 2 * hstepA;
    const size_t hstepB = (size_t)HALF * K * 2, tstepB = 2 * hstepB;
    const size_t jump = (size_t)g.a_jump;
    const unsigned ldsw = (unsigned)wid * 1024u;
    const int aoff = lds_byte(wr * 64 + fr, fq * 8), boff = lds_byte(wc * 32 + fr, fq * 8);
#define PG8_KA(tt) ((size_t)(tt) * kstep + (((tt) >= th) ? jump : (size_t)0))
#define PG8_SA(b, h) (((b) * 2 + (h)) * HTB)
#define PG8_SB(b, h) ((4 + (b) * 2 + (h)) * HTB)
#define PG8_STAGE(bufoff, gbase, voff) do { _Pragma("unroll") for (int _i = 0; _i < 2; ++_i) \
        __builtin_amdgcn_global_load_lds((const unsigned*)((const char*)(gbase) + (voff)[_i]), (LAS unsigned*)(lds + (bufoff) + ldsw + _i * 8192), 16, 0, 0); } while (0)
#define PG8_LDA(dst, b, h) do { _Pragma("unroll") for (int m = 0; m < 4; ++m) _Pragma("unroll") for (int k = 0; k < 2; ++k) dst[m][k] = *(const LAS bf16x8*)(lds + PG8_SA(b, h) + aoff + m * 2048 + k * 1024); } while (0)
#define PG8_LDB(dst, b, h) do { _Pragma("unroll") for (int n = 0; n < 2; ++n) _Pragma("unroll") for (int k = 0; k < 2; ++k) dst[n][k] = *(const LAS bf16x8*)(lds + PG8_SB(b, h) + boff + n * 2048 + k * 1024); } while (0)
#define PG8_MMA(ai, bj, At, Bt) do { __builtin_amdgcn_s_setprio(1); _Pragma("unroll") for (int m = 0; m < 4; ++m) _Pragma("unroll") for (int n = 0; n < 2; ++n) _Pragma("unroll") for (int k = 0; k < 2; ++k) \
        acc[ai][bj][m][n] = __builtin_amdgcn_mfma_f32_16x16x32_bf16(Bt[n][k], At[m][k], acc[ai][bj][m][n], 0, 0, 0); __builtin_amdgcn_s_setprio(0); } while (0)
#define PG8_WAIT_V(n) asm volatile("s_waitcnt vmcnt(" #n ")" ::: "memory")
#define PG8_WAIT_L(n) asm volatile("s_waitcnt lgkmcnt(" #n ")" ::: "memory")
#define PG8_BAR __builtin_amdgcn_s_barrier()
#define PG8_SCHED __builtin_amdgcn_sched_barrier(0)
    Unit cur, nxt; int ui = 0;
    if (!S.next(0, cur)) return;
    Acc acc;
#pragma unroll
    for (int a = 0; a < 2; ++a)
#pragma unroll
        for (int b = 0; b < 2; ++b)
#pragma unroll
            for (int m = 0; m < 4; ++m)
#pragma unroll
                for (int n = 0; n < 2; ++n) acc[a][b][m][n] = (f32x4){0.f, 0.f, 0.f, 0.f};
    bf16x8 At[4][2], B0[2][2], B1[2][2];
    const char* cA = (const char*)g.A + (size_t)cur.pm * tstepA; const char* cB = (const char*)g.Bt + ((size_t)cur.e * g.b_estride) * 2 + (size_t)cur.pn * tstepB;
    PG8_STAGE(PG8_SB(0, 0), cB, voffB); PG8_STAGE(PG8_SB(0, 1), cB + hstepB, voffB); PG8_STAGE(PG8_SA(0, 0), cA, voffA); PG8_STAGE(PG8_SA(0, 1), cA + hstepA, voffA);
    if (wr == 1) PG8_BAR;
    PG8_WAIT_V(2); PG8_BAR;
    PG8_STAGE(PG8_SB(1, 0), cB + kstep, voffB); PG8_STAGE(PG8_SA(1, 0), cA + PG8_KA(1), voffA); PG8_STAGE(PG8_SB(1, 1), cB + hstepB + kstep, voffB);
    PG8_WAIT_V(6); PG8_BAR;
    for (;;) {
        const bool has_next = S.next(ui + 1, nxt);
        const char* nA = has_next ? (const char*)g.A + (size_t)nxt.pm * tstepA : cA; const char* nB = has_next ? (const char*)g.Bt + ((size_t)nxt.e * g.b_estride) * 2 + (size_t)nxt.pn * tstepB : cB;
        for (int t = 0; t < nt; t += 2) {
            const bool last = (t == nt - 2);
            const char* a1 = cA + PG8_KA(t + 1);
            const char* a2 = last ? nA : cA + PG8_KA(t + 2); const char* b2 = last ? nB : cB + (size_t)(t + 2) * kstep;
            const char* a3 = last ? nA + PG8_KA(1) : cA + PG8_KA(t + 3); const char* b3 = b2 + kstep;
            if constexpr (Epi::HAS_MID) { if (t == th) E.mid(acc, cur, wr, wc, fr, fq); }
            PG8_LDB(B0, 0, 0); PG8_LDB(B1, 0, 1); PG8_SCHED; PG8_LDA(At, 0, 0); PG8_STAGE(PG8_SA(1, 1), a1 + hstepA, voffA);
            PG8_WAIT_V(8); PG8_WAIT_L(0); PG8_BAR; PG8_MMA(0, 0, At, B0); PG8_MMA(0, 1, At, B1); PG8_BAR; PG8_SCHED;
            PG8_LDA(At, 0, 1); PG8_STAGE(PG8_SB(0, 0), b2, voffB); PG8_STAGE(PG8_SB(0, 1), b2 + hstepB, voffB); PG8_STAGE(PG8_SA(0, 0), a2, voffA);
            PG8_WAIT_V(8); PG8_WAIT_L(0); PG8_BAR; PG8_MMA(1, 0, At, B0); PG8_MMA(1, 1, At, B1); PG8_BAR; PG8_SCHED;
            PG8_LDB(B0, 1, 0); PG8_LDB(B1, 1, 1); PG8_SCHED; PG8_LDA(At, 1, 0); PG8_STAGE(PG8_SA(0, 1), a2 + hstepA, voffA);
            PG8_WAIT_V(8); PG8_WAIT_L(0); PG8_BAR; PG8_MMA(0, 0, At, B0); PG8_MMA(0, 1, At, B1); PG8_BAR; PG8_SCHED;
            PG8_LDA(At, 1, 1); PG8_STAGE(PG8_SB(1, 0), b3, voffB); PG8_STAGE(PG8_SB(1, 1), b3 + hstepB, voffB); PG8_STAGE(PG8_SA(1, 0), a3, voffA);
            PG8_WAIT_V(8); PG8_WAIT_L(0); PG8_BAR; PG8_MMA(1, 0, At, B0); PG8_MMA(1, 1, At, B1); PG8_BAR; PG8_SCHED;
        }
        if (wr == 0) PG8_BAR;
        E(acc, cur, wr, wc, fr, fq);
        if (!has_next) break;
#pragma unroll
        for (int a = 0; a < 2; ++a)
#pragma unroll
            for (int b = 0; b < 2; ++b)
#pragma unroll
                for (int m = 0; m < 4; ++m)
#pragma unroll
                    for (int n = 0; n < 2; ++n) acc[a][b][m][n] = (f32x4){0.f, 0.f, 0.f, 0.f};
        cur = nxt; cA = nA; cB = nB; ++ui;
        if (wr == 1) PG8_BAR;
    }
    PG8_WAIT_V(0);
    PG8_BAR;
#undef PG8_KA
#undef PG8_SA
#undef PG8_SB
#undef PG8_STAGE
#undef PG8_LDA
#undef PG8_LDB
#undef PG8_MMA
#undef PG8_WAIT_V
#undef PG8_WAIT_L
#undef PG8_BAR
#undef PG8_SCHED
}

__device__ __forceinline__ void load_rstd(const float* ssq, int row0, float (&rs)[2][4]) {
#pragma unroll
    for (int ai = 0; ai < 2; ++ai)
#pragma unroll
        for (int m = 0; m < 4; ++m) { const f32x4 p = *(const f32x4*)(ssq + (size_t)(row0 + ai * HALF + m * 16) * 4); rs[ai][m] = __builtin_amdgcn_rsqf(((p.x + p.y) + (p.z + p.w)) * (1.0f / 1024.0f) + EPS); }
}
__device__ __forceinline__ float rstd_of(const float* ssq, int row) { const f32x4 p = *(const f32x4*)(ssq + (size_t)row * 4); return __builtin_amdgcn_rsqf(((p.x + p.y) + (p.z + p.w)) * (1.0f / 1024.0f) + EPS); }
__device__ __forceinline__ u32x4 pack8(const f32x4 v0, const f32x4 v1) { u32x4 w; w.x = cvt_pk_bf16(v0[0], v0[1]); w.y = cvt_pk_bf16(v0[2], v0[3]); w.z = cvt_pk_bf16(v1[0], v1[1]); w.w = cvt_pk_bf16(v1[2], v1[3]); return w; }

struct EpiG1a {
    static constexpr bool HAS_MID = false;
    bf16_t* P; const float* ssq; const float* LB;
    __device__ __forceinline__ void operator()(const Acc& acc, const Unit& u, int wr, int wc, int fr_, int fq_) const {
        int fr = fr_, fq = fq_; asm volatile("" : "+v"(fr), "+v"(fq));
        const int grp = u.pn >> 2, row0 = u.pm * BM + wr * 64 + fr, col0 = u.pn * BM + wc * 32 + 8 * fq;
        float rs[2][4]; load_rstd(ssq, row0, rs);
        if (grp == 1) {
            f32x4 lb[2][2];
#pragma unroll
            for (int bj = 0; bj < 2; ++bj)
#pragma unroll
                for (int n = 0; n < 2; ++n) lb[bj][n] = *(const f32x4*)(LB + (col0 - 1024) + bj * HALF + 4 * n);
#pragma unroll
            for (int ai = 0; ai < 2; ++ai)
#pragma unroll
                for (int m = 0; m < 4; ++m) { bf16_t* rowp = P + (size_t)(row0 + ai * HALF + m * 16) * 4096 + col0; const float r = rs[ai][m];
#pragma unroll
                    for (int bj = 0; bj < 2; ++bj) { f32x4 o[2];
#pragma unroll
                        for (int n = 0; n < 2; ++n)
#pragma unroll
                            for (int j = 0; j < 4; ++j) { const float z = acc[ai][bj][m][n][j] * r, l = lb[bj][n][j]; const float f = l + (1.0f - l) * sigmoidf_(z); o[n][j] = __logf(fmaxf(f, 1e-6f)); }
                        *(u32x4*)(rowp + bj * HALF) = pack8(o[0], o[1]); } }
        } else {
#pragma unroll
            for (int ai = 0; ai < 2; ++ai)
#pragma unroll
                for (int m = 0; m < 4; ++m) { bf16_t* rowp = P + (size_t)(row0 + ai * HALF + m * 16) * 4096 + col0; const float r = rs[ai][m];
#pragma unroll
                    for (int bj = 0; bj < 2; ++bj) { f32x4 o[2];
#pragma unroll
                        for (int n = 0; n < 2; ++n)
#pragma unroll
                            for (int j = 0; j < 4; ++j) { const float z = acc[ai][bj][m][n][j] * r; o[n][j] = (grp == 0) ? siluf_(z) * QSCALE : (grp == 3) ? siluf_(z) : z; }
                        *(u32x4*)(rowp + bj * HALF) = pack8(o[0], o[1]); } }
        }
    }
};
struct EpiG1b {
    static constexpr bool HAS_MID = false;
    bf16_t* P; bf16_t* SB; const float* ssq;
    __device__ __forceinline__ void operator()(const Acc& acc, const Unit& u, int wr, int wc, int fr_, int fq_) const {
        int fr = fr_, fq = fq_; asm volatile("" : "+v"(fr), "+v"(fq));
        const int row0 = u.pm * BM + wr * 64 + fr, cw = wc * 32 + 8 * fq;
        float rs[2][4]; load_rstd(ssq, row0, rs);
        if (u.pn < 8) {
#pragma unroll
            for (int ai = 0; ai < 2; ++ai)
#pragma unroll
                for (int m = 0; m < 4; ++m) { const float r2 = rs[ai][m] * rs[ai][m]; f32x4 o[2];
#pragma unroll
                    for (int n = 0; n < 2; ++n) o[n] = acc[ai][0][m][n] * acc[ai][1][m][n] * r2;
                    *(u32x4*)(P + (size_t)(row0 + ai * HALF + m * 16) * 4096 + 1024 + u.pn * HALF + cw) = pack8(o[0], o[1]); }
        } else {
            const int t = u.pn - 8, grp = t >> 2;
            bf16_t* base = (grp == 2) ? SB : P + 2048 + grp * 1024; const size_t ld = (grp == 2) ? 1024 : 4096; const int col0 = (t & 3) * BM + cw;
#pragma unroll
            for (int ai = 0; ai < 2; ++ai)
#pragma unroll
                for (int m = 0; m < 4; ++m) { bf16_t* rowp = base + (size_t)(row0 + ai * HALF + m * 16) * ld + col0; const float r = rs[ai][m];
#pragma unroll
                    for (int bj = 0; bj < 2; ++bj) { f32x4 o[2];
#pragma unroll
                        for (int n = 0; n < 2; ++n)
#pragma unroll
                            for (int j = 0; j < 4; ++j) { const float z = acc[ai][bj][m][n][j] * r; o[n][j] = (grp == 0) ? z : sigmoidf_(z); }
                        *(u32x4*)(rowp + bj * HALF) = pack8(o[0], o[1]); } }
        }
    }
};
struct EpiG2 {
    static constexpr bool HAS_MID = true;
    bf16_t* P; const bf16_t* SB;
    __device__ __forceinline__ void mid(Acc& acc, const Unit& u, int wr, int wc, int fr_, int fq_) const {
        int fr = fr_, fq = fq_; asm volatile("" : "+v"(fr), "+v"(fq));
        const int row0 = u.pm * BM + wr * 64 + fr, col0 = u.pn * BM + wc * 32 + 8 * fq;
#pragma unroll
        for (int ai = 0; ai < 2; ++ai)
#pragma unroll
            for (int m = 0; m < 4; ++m) { const size_t row = (size_t)(row0 + ai * HALF + m * 16);
#pragma unroll
                for (int bj = 0; bj < 2; ++bj) { const u32x4 a = *(const u32x4*)(P + row * 4096 + 3072 + col0 + bj * HALF), b = *(const u32x4*)(SB + row * 1024 + col0 + bj * HALF);
#pragma unroll
                    for (int q = 0; q < 4; ++q) { const float r0 = bf_lo(a[q]) * __builtin_amdgcn_rcpf(fmaxf(bf_lo(b[q]), 1e-20f)), r1 = bf_hi(a[q]) * __builtin_amdgcn_rcpf(fmaxf(bf_hi(b[q]), 1e-20f));
                        acc[ai][bj][m][q >> 1][(q & 1) * 2] *= r0; acc[ai][bj][m][q >> 1][(q & 1) * 2 + 1] *= r1; } }
                asm volatile("" ::: "memory"); }
    }
    __device__ __forceinline__ void operator()(const Acc& acc, const Unit& u, int wr, int wc, int fr_, int fq_) const {
        int fr = fr_, fq = fq_; asm volatile("" : "+v"(fr), "+v"(fq));
        const int row0 = u.pm * BM + wr * 64 + fr, col0 = u.pn * BM + wc * 32 + 8 * fq;
#pragma unroll
        for (int ai = 0; ai < 2; ++ai)
#pragma unroll
            for (int m = 0; m < 4; ++m) { const size_t row = (size_t)(row0 + ai * HALF + m * 16);
#pragma unroll
                for (int bj = 0; bj < 2; ++bj) { const u32x4 b = *(const u32x4*)(SB + row * 1024 + col0 + bj * HALF); f32x4 o[2];
#pragma unroll
                    for (int q = 0; q < 4; ++q) { o[q >> 1][(q & 1) * 2] = acc[ai][bj][m][q >> 1][(q & 1) * 2] * bf_lo(b[q]); o[q >> 1][(q & 1) * 2 + 1] = acc[ai][bj][m][q >> 1][(q & 1) * 2 + 1] * bf_hi(b[q]); }
                    *(u32x4*)(P + row * 4096 + 1024 + col0 + bj * HALF) = pack8(o[0], o[1]); }
                asm volatile("" ::: "memory"); }
    }
};
struct EpiRes {
    static constexpr bool HAS_MID = false;
    float* X; bf16_t* XB; float* ssq_out; LAS float* red;
    __device__ __forceinline__ void operator()(const Acc& acc, const Unit& u, int wr, int wc, int fr_, int fq_) const {
        int fr = fr_, fq = fq_; asm volatile("" : "+v"(fr), "+v"(fq));
        const int row0 = u.pm * BM + wr * 64 + fr, col0 = u.pn * BM + wc * 32 + 8 * fq;
#pragma unroll
        for (int ai = 0; ai < 2; ++ai)
#pragma unroll
            for (int m = 0; m < 4; ++m) { const size_t row = (size_t)(row0 + ai * HALF + m * 16); float* xr = X + row * 1024 + col0; float s = 0.f;
#pragma unroll
                for (int bj = 0; bj < 2; ++bj) { f32x4 v0 = *(const f32x4*)(xr + bj * HALF) + acc[ai][bj][m][0], v1 = *(const f32x4*)(xr + bj * HALF + 4) + acc[ai][bj][m][1];
                    *(f32x4*)(xr + bj * HALF) = v0; *(f32x4*)(xr + bj * HALF + 4) = v1; *(u32x4*)(XB + row * 1024 + col0 + bj * HALF) = pack8(v0, v1);
                    s += (v0[0] * v0[0] + v0[1] * v0[1]) + (v0[2] * v0[2] + v0[3] * v0[3]) + (v1[0] * v1[0] + v1[1] * v1[1]) + (v1[2] * v1[2] + v1[3] * v1[3]); }
                s += __shfl_xor(s, 16); s += __shfl_xor(s, 32);
                if (fq == 0) red[(ai * HALF + wr * 64 + m * 16 + fr) * 4 + wc] = s;
                asm volatile("" ::: "memory"); }
        asm volatile("s_waitcnt lgkmcnt(0)" ::: "memory"); __builtin_amdgcn_s_barrier(); asm volatile("" ::: "memory");
        const int t = threadIdx.x;
        if (t < 256) { const f32x4 p = *(const LAS f32x4*)(red + t * 4); ssq_out[(size_t)(u.pm * BM + t) * 4 + u.pn] = (p.x + p.y) + (p.z + p.w); }
    }
};
template <bool SLOT> struct EpiSwiglu {
    static constexpr bool HAS_MID = false;
    bf16_t* H; const float* rsrc;
    __device__ __forceinline__ void operator()(const Acc& acc, const Unit& u, int wr, int wc, int fr_, int fq_) const {
        int fr = fr_, fq = fq_; asm volatile("" : "+v"(fr), "+v"(fq));
        const int row0 = u.pm * BM + wr * 64 + fr, col0 = u.pn * HALF + wc * 32 + 8 * fq;
        float rs[2][4];
        if constexpr (SLOT) {
#pragma unroll
            for (int ai = 0; ai < 2; ++ai)
#pragma unroll
                for (int m = 0; m < 4; ++m) rs[ai][m] = __hip_atomic_load(rsrc + row0 + ai * HALF + m * 16, RLX_AGENT);
        } else load_rstd(rsrc, row0, rs);
#pragma unroll
        for (int ai = 0; ai < 2; ++ai)
#pragma unroll
            for (int m = 0; m < 4; ++m) { const float r = rs[ai][m]; f32x4 o[2];
#pragma unroll
                for (int n = 0; n < 2; ++n)
#pragma unroll
                    for (int j = 0; j < 4; ++j) o[n][j] = siluf_(acc[ai][0][m][n][j] * r) * (acc[ai][1][m][n][j] * r);
                *(u32x4*)(H + (size_t)(row0 + ai * HALF + m * 16) * DFF + col0) = pack8(o[0], o[1]); }
    }
};
struct EpiDown {
    static constexpr bool HAS_MID = false;
    float* X; const int* tok; const float* gate;
    __device__ __forceinline__ void operator()(const Acc& acc, const Unit& u, int wr, int wc, int fr_, int fq_) const {
        int fr = fr_, fq = fq_; asm volatile("" : "+v"(fr), "+v"(fq));
        const int row0 = u.pm * BM + wr * 64 + fr, col0 = u.pn * BM + wc * 32 + 8 * fq;
#pragma unroll
        for (int ai = 0; ai < 2; ++ai)
#pragma unroll
            for (int m = 0; m < 4; ++m) { const int row = row0 + ai * HALF + m * 16; const int tk = __hip_atomic_load(tok + row, RLX_AGENT); const float gt = __hip_atomic_load(gate + row, RLX_AGENT);
                if (tk >= 0) { float* xr = X + (size_t)tk * 1024 + col0;
#pragma unroll
                    for (int bj = 0; bj < 2; ++bj) { const f32x4 v0 = *(const f32x4*)(xr + bj * HALF) + acc[ai][bj][m][0] * gt, v1 = *(const f32x4*)(xr + bj * HALF + 4) + acc[ai][bj][m][1] * gt;
                        *(f32x4*)(xr + bj * HALF) = v0; *(f32x4*)(xr + bj * HALF + 4) = v1; } }
                asm volatile("" ::: "memory"); }
    }
};
}

#define XB_TMO      128
#define XB_XCNT(j)  (256  + 64 * (j))
#define XB_XSUB(j)  (1280 + 64 * (j))
#define XB_XGEN(j)  (2304 + 64 * (j))
#define XB_TOP      3328
#define XB_TOPGEN   3392
#define XCD_BAR_WORDS 3456
#define XB_SPIN_CAP (1u << 18)
__device__ __forceinline__ unsigned xb_ld(unsigned* p)              { return __hip_atomic_load(p, __ATOMIC_RELAXED, __HIP_MEMORY_SCOPE_AGENT); }
__device__ __forceinline__ unsigned xb_add(unsigned* p, unsigned v) { return __hip_atomic_fetch_add(p, v, __ATOMIC_RELAXED, __HIP_MEMORY_SCOPE_AGENT); }
__device__ __forceinline__ unsigned xb_xcc_id() { return (unsigned)__builtin_amdgcn_s_getreg((3 << 11) | 20) & 0xFu; }
#define XB_SPIN(cond, bar) do { unsigned _sp = 0; while (cond) { __builtin_amdgcn_s_sleep(1); \
    if ((++_sp & 255u) == 0u) { if (xb_ld(&(bar)[XB_TMO])) break; if (_sp > XB_SPIN_CAP) { atomicAdd(&(bar)[XB_TMO], 1u); break; } } } } while (0)
struct XcdBarrier { unsigned* bar; unsigned x; volatile LAS unsigned* st; };
__device__ __forceinline__ XcdBarrier xcd_barrier_post(unsigned* bar, volatile LAS unsigned* st) {
    XcdBarrier b; b.bar = bar; b.x = xb_xcc_id(); b.st = st;
    if (threadIdx.x == 0) (void)xb_add(&bar[XB_XCNT(b.x)], 1u);
    return b;
}
__device__ __forceinline__ void xcd_barrier_complete(unsigned* bar, unsigned x, unsigned& nloc, unsigned& nx) {
    const unsigned G = gridDim.x * gridDim.y * gridDim.z;
    unsigned sum, cnt, mine, sp = 0u;
    for (;;) {
        sum = 0u; cnt = 0u; mine = 0u;
#pragma unroll
        for (unsigned j = 0; j < 16; ++j) { const unsigned c = xb_ld(&bar[XB_XCNT(j)]); sum += c; cnt += (c > 0u) ? 1u : 0u; mine = (j == x) ? c : mine; }
        if (sum == G) break;
        __builtin_amdgcn_s_sleep(1);
        if ((++sp & 255u) == 0u) { if (xb_ld(&bar[XB_TMO])) break; if (sp > XB_SPIN_CAP) { atomicAdd(&bar[XB_TMO], 1u); break; } }
    }
    nloc = mine > 0u ? mine : 1u; nx = cnt > 0u ? cnt : 1u;
}
__device__ __forceinline__ void xcd_barrier(const XcdBarrier& b) {
    asm volatile("s_waitcnt vmcnt(0)" ::: "memory");
    __syncthreads();
    if (threadIdx.x == 0) {
        unsigned* bar = b.bar;
        __builtin_amdgcn_s_waitcnt(0);
        unsigned nloc = b.st[0], nx = b.st[1];
        if (nloc == 0u) { xcd_barrier_complete(bar, b.x, nloc, nx); b.st[0] = nloc; b.st[1] = nx; }
        const unsigned old = xb_add(&bar[XB_XSUB(b.x)], 1u);
        const unsigned gen = old / nloc;
        if (old + 1u == (gen + 1u) * nloc) {
            __builtin_amdgcn_fence(__ATOMIC_RELEASE, "agent");
            asm volatile("s_waitcnt vmcnt(0)" ::: "memory");
            const unsigned og = xb_add(&bar[XB_TOP], 1u);
            const unsigned tg = og / nx;
            if (og + 1u == (tg + 1u) * nx) xb_add(&bar[XB_TOPGEN], 1u);
            else XB_SPIN(xb_ld(&bar[XB_TOPGEN]) == tg, bar);
            __builtin_amdgcn_fence(__ATOMIC_ACQUIRE, "agent");
            xb_add(&bar[XB_XGEN(b.x)], 1u);
            asm volatile("s_waitcnt vmcnt(0)" ::: "memory");
        } else {
            XB_SPIN(xb_ld(&bar[XB_XGEN(b.x)]) == gen, bar);
            __builtin_amdgcn_fence(__ATOMIC_ACQUIRE, "agent");
            asm volatile("s_waitcnt vmcnt(0)" ::: "memory");
        }
    }
    __syncthreads();
}

struct Frame {
    LAS unsigned char* lds; volatile LAS unsigned* MISC;
    int tid, lane, wave, vcu, G, rot;
    unsigned char* ws; float* X;
    const float* const* in;
};
#define LDS_WAIT() asm volatile("s_waitcnt lgkmcnt(0)" ::: "memory")
__device__ __forceinline__ float wave_sum(float v) {
#pragma unroll
    for (int o = 1; o < 64; o <<= 1) v += __shfl_xor(v, o);
    return v;
}
__device__ __forceinline__ unsigned f2bf(float f) { unsigned u = __builtin_bit_cast(unsigned, f); return (u + 0x7fffu + ((u >> 16) & 1u)) >> 16; }
__device__ __forceinline__ unsigned pk2(float lo, float hi) { return f2bf(lo) | (f2bf(hi) << 16); }
__device__ __forceinline__ float bf2f(bf16_t b) { return __uint_as_float(((unsigned)b) << 16); }

struct Job { const float* src; int ldsrc, K, ncb, c0; bf16_t* dst; int lddst, dk0, kind, base; const float* scale; };
__device__ __forceinline__ void transpose_item(const Job& j, int item, LAS float* scr, int lane) {
    const int kb = item / j.ncb, nb = item % j.ncb, k0 = 64 * kb, cl = 32 * nb;
    const int drow0 = (j.kind == 0) ? j.base + cl : 256 * (cl >> 7) + (cl & 127) + j.base;
#pragma unroll 8
    for (int i = 0; i < 32; ++i) { const int kk = 2 * i + (lane >> 5); float v = j.src[(size_t)(k0 + kk) * j.ldsrc + j.c0 + cl + (lane & 31)]; if (j.scale) v *= j.scale[k0 + kk]; scr[kk * 33 + (lane & 31)] = v; }
    LDS_WAIT(); asm volatile("" ::: "memory");
    const int c = lane & 7;
#pragma unroll
    for (int jj = 0; jj < 4; ++jj) { const int n = (lane >> 3) + 8 * jj; const LAS float* s = scr + (8 * c) * 33 + n;
        u32x4 o; o.x = pk2(s[0 * 33], s[1 * 33]); o.y = pk2(s[2 * 33], s[3 * 33]); o.z = pk2(s[4 * 33], s[5 * 33]); o.w = pk2(s[6 * 33], s[7 * 33]);
        *(GAS u32x4*)(j.dst + (size_t)(drow0 + n) * j.lddst + j.dk0 + k0 + 8 * c) = o; }
    LDS_WAIT(); asm volatile("" ::: "memory");
}
__device__ __forceinline__ void run_job(Frame& F, const Job& j) {
    LAS float* scr = (LAS float*)(F.lds + F.wave * 16384);
    const int gw = F.vcu * NWAVES + F.wave, NGW = F.G * NWAVES, nit = (j.K / 64) * j.ncb;
    int first = gw - F.rot; if (first < 0) first += NGW;
    for (int it = first; it < nit; it += NGW) transpose_item(j, it, scr, F.lane);
    F.rot = (F.rot + nit) % NGW;
}
enum { I_X = 0, I_WIN, I_LB, I_GNW, I_CONVW, I_WPH, I_WPC, I_WOUT, I_NMIX, I_NFFN, I_DW1, I_DW3, I_DW2, I_RW, I_EW1, I_EW3, I_EW2, I_FN };

__device__ __forceinline__ void p_prologue(Frame& F) {
    F.rot = 0;
    bf16_t* W = (bf16_t*)(F.ws + WS_WNE);
    for (int L = 0; L < 2; ++L) {
        const float* win = F.in[I_WIN] + (size_t)L * D * INW; const float* nm = F.in[I_NMIX] + L * D;
        bf16_t* wa = W + WN_INA + (size_t)L * 4096 * 1024; bf16_t* wb = W + WN_INB + (size_t)L * 5120 * 1024;
        run_job(F, Job{win, INW, D, 128, 0, wa, 1024, 0, 0, 0, nm});
        run_job(F, Job{win, INW, D, 32, 4096, wb, 1024, 0, 1, 0, nm});
        run_job(F, Job{win, INW, D, 32, 6144, wb, 1024, 0, 1, 128, nm});
        run_job(F, Job{win, INW, D, 32, 5120, wb, 1024, 0, 0, 2048, nm});
        run_job(F, Job{win, INW, D, 32, 7168, wb, 1024, 0, 0, 3072, nm});
        run_job(F, Job{win, INW, D, 32, 8192, wb, 1024, 0, 0, 4096, nm});
        bf16_t* wp = W + WN_PROJ + (size_t)L * 1024 * 2048;
        run_job(F, Job{F.in[I_WPH] + (size_t)L * D * D, D, D, 32, 0, wp, 2048, 0, 0, 0, nullptr});
        run_job(F, Job{F.in[I_WPC] + (size_t)L * D * D, D, D, 32, 0, wp, 2048, 1024, 0, 0, nullptr});
        run_job(F, Job{F.in[I_WOUT] + (size_t)L * D * D, D, D, 32, 0, W + WN_OUT + (size_t)L * D * D, 1024, 0, 0, 0, nullptr});
    }
    run_job(F, Job{F.in[I_DW1], DFF, D, 88, 0, W + WN_D13, 1024, 0, 1, 0, F.in[I_NFFN]});
    run_job(F, Job{F.in[I_DW3], DFF, D, 88, 0, W + WN_D13, 1024, 0, 1, 128, F.in[I_NFFN]});
    run_job(F, Job{F.in[I_DW2], D, DFF, 32, 0, W + WN_D2, DFF, 0, 0, 0, nullptr});
    const int gw = F.vcu * NWAVES + F.wave, NGW = F.G * NWAVES;
    f32x4* ssq0 = (f32x4*)(F.ws + OFF_SSQ); bf16_t* XB = (bf16_t*)(F.ws + WS_XB);
    for (int m = gw; m < T; m += NGW) {
        const GAS f32x4* xr = (const GAS f32x4*)(F.in[I_X] + (size_t)m * D) + F.lane; GAS f32x4* xo = (GAS f32x4*)(F.X + (size_t)m * D) + F.lane;
        GAS unsigned long long* o8 = (GAS unsigned long long*)(XB + (size_t)m * D) + F.lane; float s = 0.f;
#pragma unroll
        for (int j = 0; j < 4; ++j) { const f32x4 v = xr[64 * j]; xo[64 * j] = v; s += (v.x * v.x + v.y * v.y) + (v.z * v.z + v.w * v.w);
            o8[64 * j] = (unsigned long long)pk2(v.x, v.y) | ((unsigned long long)pk2(v.z, v.w) << 32); }
        s = wave_sum(s); if (F.lane == 0) ssq0[m] = (f32x4){s, 0.f, 0.f, 0.f};
    }
    if (blockIdx.x == 0) { float* LBp = (float*)(F.ws + OFF_LB);
        for (int c = F.tid; c < 1024; c += NWAVES * 64) { const float l0 = F.in[I_LB][c], l1 = F.in[I_LB][1024 + c]; LBp[c] = 0.f; LBp[1024 + c] = 1.0f / (1.0f + __expf(l0 - l1)); } }
}
__device__ __forceinline__ void p_convert_experts(Frame& F) {
    F.rot = 0;
    bf16_t* W = (bf16_t*)(F.ws + WS_WE); const float* nf = F.in[I_NFFN] + D;
    for (int e = 0; e < NE; ++e) {
        bf16_t* w13 = W + WE_13 + (size_t)e * 5632 * 1024;
        run_job(F, Job{F.in[I_EW1] + (size_t)e * D * DFF, DFF, D, 88, 0, w13, 1024, 0, 1, 0, nf});
        run_job(F, Job{F.in[I_EW3] + (size_t)e * D * DFF, DFF, D, 88, 0, w13, 1024, 0, 1, 128, nf});
        run_job(F, Job{F.in[I_EW2] + (size_t)e * DFF * D, D, DFF, 32, 0, W + WE_2 + (size_t)e * 1024 * DFF, DFF, 0, 0, 0, nullptr});
    }
}

__device__ __forceinline__ void p_scan(Frame& F) {
    const bf16_t* P = (const bf16_t*)(F.ws + WS_P); bf16_t* O = (bf16_t*)(F.ws + WS_S);
    LAS f32x2* LQ = (LAS f32x2*)(F.lds);
    LAS float* IV = (LAS float*)(F.lds + 16384);
    LAS float* PART = (LAS float*)(F.lds + 16384 + 1024);
    const int tid = F.tid, k = tid >> 2, vq = tid & 3;
    for (int wi = F.vcu; wi < 256; wi += F.G) {
        const int bh = wi >> 3, vs = wi & 7, b = bh >> 3, h = bh & 7;
        const size_t rbase = (size_t)b * SEQ;
        const int lr = tid >> 5, lk = (tid & 31) * 4;
        float S0 = 0.f, S1 = 0.f, S2 = 0.f, S3 = 0.f;
        u32x2 rq, rf, rv = (u32x2){0u, 0u};
        { const bf16_t* rp = P + (rbase + lr) * 4096 + h * 128; rq = *(const u32x2*)(rp + lk); rf = *(const u32x2*)(rp + 1024 + lk);
          if (tid < 64) rv = *(const u32x2*)(P + (rbase + (tid >> 2)) * 4096 + 2048 + h * 128 + vs * 16 + (tid & 3) * 4); }
        for (int t0 = 0; t0 < SEQ; t0 += 16) {
            LQ[lr * 128 + lk + 0] = (f32x2){pg8::bf_lo(rf.x), pg8::bf_lo(rq.x)}; LQ[lr * 128 + lk + 1] = (f32x2){pg8::bf_hi(rf.x), pg8::bf_hi(rq.x)};
            LQ[lr * 128 + lk + 2] = (f32x2){pg8::bf_lo(rf.y), pg8::bf_lo(rq.y)}; LQ[lr * 128 + lk + 3] = (f32x2){pg8::bf_hi(rf.y), pg8::bf_hi(rq.y)};
            if (tid < 64) { LAS float* iv = IV + (tid >> 2) * 16 + (tid & 3) * 4; iv[0] = pg8::bf_lo(rv.x); iv[1] = pg8::bf_hi(rv.x); iv[2] = pg8::bf_lo(rv.y); iv[3] = pg8::bf_hi(rv.y); }
            __syncthreads();
            if (t0 + 16 < SEQ) { const bf16_t* rp = P + (rbase + t0 + 16 + lr) * 4096 + h * 128; rq = *(const u32x2*)(rp + lk); rf = *(const u32x2*)(rp + 1024 + lk);
                if (tid < 64) rv = *(const u32x2*)(P + (rbase + t0 + 16 + (tid >> 2)) * 4096 + 2048 + h * 128 + vs * 16 + (tid & 3) * 4); }
#pragma unroll 4
            for (int tt = 0; tt < 16; ++tt) {
                const f32x2 lq = LQ[tt * 128 + k]; const f32x4 iv = *(const LAS f32x4*)(IV + tt * 16 + vq * 4);
                const float f = __expf(lq.x), kk = 1.0f - f, q = lq.y;
                S0 = f * S0 + kk * iv.x; S1 = f * S1 + kk * iv.y; S2 = f * S2 + kk * iv.z; S3 = f * S3 + kk * iv.w;
                float p0 = q * S0, p1 = q * S1, p2 = q * S2, p3 = q * S3;
#pragma unroll
                for (int o = 4; o < 64; o <<= 1) { p0 += __shfl_xor(p0, o); p1 += __shfl_xor(p1, o); p2 += __shfl_xor(p2, o); p3 += __shfl_xor(p3, o); }
                if ((F.lane >> 2) == 0) *(LAS f32x4*)(PART + (tt * 8 + F.wave) * 16 + vq * 4) = (f32x4){p0, p1, p2, p3};
            }
            __syncthreads();
            if (tid < 256) { const int tt = tid >> 4, v = tid & 15; float s = 0.f;
#pragma unroll
                for (int w = 0; w < 8; ++w) s += PART[(tt * 8 + w) * 16 + v];
                O[(rbase + t0 + tt) * 1024 + h * 128 + vs * 16 + v] = (bf16_t)f2bf(s); }
        }
        __syncthreads();
    }
}
__device__ __forceinline__ void p_onorm(Frame& F, int L) {
    bf16_t* P = (bf16_t*)(F.ws + WS_P); const bf16_t* O = (const bf16_t*)(F.ws + WS_S); const float* gw = F.in[I_GNW] + L * HV;
    const int gw_ = F.vcu * NWAVES + F.wave, NGW = F.G * NWAVES, c0 = (F.lane & 7) * 16;
    float g[16];
#pragma unroll
    for (int j = 0; j < 16; ++j) g[j] = gw[c0 + j];
    for (int m = gw_; m < T; m += NGW) {
        const u32x4 o0 = *(const u32x4*)(O + (size_t)m * 1024 + F.lane * 16), o1 = *(const u32x4*)(O + (size_t)m * 1024 + F.lane * 16 + 8);
        const u32x4 s0 = *(const u32x4*)(P + (size_t)m * 4096 + 3072 + F.lane * 16), s1 = *(const u32x4*)(P + (size_t)m * 4096 + 3072 + F.lane * 16 + 8);
        float v[16], sg[16];
#pragma unroll
        for (int q = 0; q < 4; ++q) { v[2 * q] = pg8::bf_lo(o0[q]); v[2 * q + 1] = pg8::bf_hi(o0[q]); v[8 + 2 * q] = pg8::bf_lo(o1[q]); v[8 + 2 * q + 1] = pg8::bf_hi(o1[q]);
            sg[2 * q] = pg8::bf_lo(s0[q]); sg[2 * q + 1] = pg8::bf_hi(s0[q]); sg[8 + 2 * q] = pg8::bf_lo(s1[q]); sg[8 + 2 * q + 1] = pg8::bf_hi(s1[q]); }
        float s = 0.f;
#pragma unroll
        for (int j = 0; j < 16; ++j) s += v[j] * v[j];
        s += __shfl_xor(s, 1); s += __shfl_xor(s, 2); s += __shfl_xor(s, 4);
        const float r = __builtin_amdgcn_rsqf(s * (1.0f / 128.0f) + EPS);
        u32x4 w0, w1;
#pragma unroll
        for (int q = 0; q < 4; ++q) { w0[q] = pk2(v[2 * q] * r * g[2 * q] * sg[2 * q], v[2 * q + 1] * r * g[2 * q + 1] * sg[2 * q + 1]);
            w1[q] = pk2(v[8 + 2 * q] * r * g[8 + 2 * q] * sg[8 + 2 * q], v[8 + 2 * q + 1] * r * g[8 + 2 * q + 1] * sg[8 + 2 * q + 1]); }
        *(u32x4*)(P + (size_t)m * 4096 + F.lane * 16) = w0; *(u32x4*)(P + (size_t)m * 4096 + F.lane * 16 + 8) = w1;
    }
}
__device__ __forceinline__ void p_conv(Frame& F, int L) {
    bf16_t* P = (bf16_t*)(F.ws + WS_P); const float* cw = F.in[I_CONVW] + (size_t)L * 3 * D;
    const int cb = (F.tid & 127) * 8, rsub = F.tid >> 7;
    float w0[8], w1[8], w2[8];
#pragma unroll
    for (int j = 0; j < 8; ++j) { w0[j] = cw[cb + j]; w1[j] = cw[D + cb + j]; w2[j] = cw[2 * D + cb + j]; }
    const int rows_per = T / F.G;
    for (int rr = rsub; rr < rows_per; rr += 4) {
        const int m = F.vcu * rows_per + rr, t = m & (SEQ - 1);
        const u32x4 z = (u32x4){0u, 0u, 0u, 0u};
        const u32x4 v2 = *(const u32x4*)(P + (size_t)m * 4096 + 1024 + cb);
        const u32x4 v1 = (t >= 1) ? *(const u32x4*)(P + (size_t)(m - 1) * 4096 + 1024 + cb) : z;
        const u32x4 v0 = (t >= 2) ? *(const u32x4*)(P + (size_t)(m - 2) * 4096 + 1024 + cb) : z;
        const u32x4 c = *(const u32x4*)(P + (size_t)m * 4096 + 2048 + cb);
        u32x4 o;
#pragma unroll
        for (int q = 0; q < 4; ++q) {
            const float a = pg8::bf_lo(c[q]) * (w0[2 * q] * pg8::bf_lo(v0[q]) + w1[2 * q] * pg8::bf_lo(v1[q]) + w2[2 * q] * pg8::bf_lo(v2[q]));
            const float b = pg8::bf_hi(c[q]) * (w0[2 * q + 1] * pg8::bf_hi(v0[q]) + w1[2 * q + 1] * pg8::bf_hi(v1[q]) + w2[2 * q + 1] * pg8::bf_hi(v2[q]));
            o[q] = pk2(a, b); }
        *(u32x4*)(P + (size_t)m * 4096 + 2048 + cb) = o;
    }
}
__device__ __forceinline__ void p_route1(Frame& F) {
    LAS float* RW = (LAS float*)F.lds;
    LAS unsigned* CNT = (LAS unsigned*)(F.lds + 32768);
    const float* nf = F.in[I_NFFN] + D; const float* rw = F.in[I_RW];
    for (int i = F.tid; i < 8192; i += NWAVES * 64) RW[i] = rw[i] * nf[i >> 3];
    if (F.tid < 16) CNT[F.tid] = 0u;
    __syncthreads();
    const float* ssq = (const float*)(F.ws + OFF_SSQ) + (size_t)3 * T * 4;
    f32x4* route = (f32x4*)(F.ws + OFF_ROUTE);
    const int per = T / F.G;
    for (int i = F.wave; i < per; i += NWAVES) {
        const int m = F.vcu * per + i;
        float lg[8];
#pragma unroll
        for (int e = 0; e < 8; ++e) lg[e] = 0.f;
#pragma unroll
        for (int j = 0; j < 4; ++j) { const f32x4 v = *((const GAS f32x4*)(F.X + (size_t)m * D) + F.lane + 64 * j); const int k0 = (F.lane + 64 * j) * 4;
#pragma unroll
            for (int q = 0; q < 4; ++q) { const f32x4 r0 = *(const LAS f32x4*)(RW + (k0 + q) * 8), r1 = *(const LAS f32x4*)(RW + (k0 + q) * 8 + 4);
                lg[0] += v[q] * r0.x; lg[1] += v[q] * r0.y; lg[2] += v[q] * r0.z; lg[3] += v[q] * r0.w; lg[4] += v[q] * r1.x; lg[5] += v[q] * r1.y; lg[6] += v[q] * r1.z; lg[7] += v[q] * r1.w; } }
#pragma unroll
        for (int e = 0; e < 8; ++e) lg[e] = wave_sum(lg[e]);
        const float rstd = pg8::rstd_of(ssq, m);
        int e1 = 0; float v1 = lg[0];
#pragma unroll
        for (int e = 1; e < 8; ++e) if (lg[e] > v1) { v1 = lg[e]; e1 = e; }
        int e2 = -1; float v2 = -3.0e38f;
#pragma unroll
        for (int e = 0; e < 8; ++e) if (e != e1 && lg[e] > v2) { v2 = lg[e]; e2 = e; }
        const float g1 = 1.0f / (1.0f + __expf((v2 - v1) * rstd)), g2 = 1.0f - g1;
        if (F.lane == 0) { route[m] = (f32x4){__int_as_float(e1), __int_as_float(e2), g1, g2}; __hip_atomic_fetch_add(CNT + e1, 1u, __ATOMIC_RELAXED, __HIP_MEMORY_SCOPE_WORKGROUP); __hip_atomic_fetch_add(CNT + 8 + e2, 1u, __ATOMIC_RELAXED, __HIP_MEMORY_SCOPE_WORKGROUP); }
    }
    __syncthreads();
    if (F.tid < 16) __hip_atomic_store((unsigned*)(F.ws + OFF_BLKCNT) + F.vcu * 16 + F.tid, CNT[F.tid], RLX_AGENT);
}
__device__ __forceinline__ void p_route2(Frame& F) {
    LAS unsigned* TOT = (LAS unsigned*)F.lds;
    LAS unsigned* PRE = TOT + 16;
    LAS unsigned* BASE = PRE + 16;
    LAS unsigned* PT = BASE + 16;
    LAS f32x4* RT = (LAS f32x4*)(F.lds + 8192);
    LAS float* RS = (LAS float*)(F.lds + 8192 + 4096);
    const unsigned* bc = (const unsigned*)(F.ws + OFF_BLKCNT);
    const f32x4* route = (const f32x4*)(F.ws + OFF_ROUTE); const float* ssq = (const float*)(F.ws + OFF_SSQ) + (size_t)3 * T * 4;
    const int per = T / F.G;
    { const int ent = F.tid & 15, ch = F.tid >> 4; unsigned tot = 0, pre = 0;
      for (int b = ch * 8; b < ch * 8 + 8 && b < F.G; ++b) { const unsigned c = __hip_atomic_load(bc + b * 16 + ent, RLX_AGENT); tot += c; if (b < F.vcu) pre += c; }
      PT[ch * 16 + ent] = tot; PT[512 + ch * 16 + ent] = pre; }
    for (int i = F.tid; i < per; i += NWAVES * 64) { const int m = F.vcu * per + i; RT[i] = route[m]; RS[i] = pg8::rstd_of(ssq, m); }
    __syncthreads();
    if (F.tid < 16) { unsigned tot = 0, pre = 0; for (int ch = 0; ch < 32; ++ch) { tot += PT[ch * 16 + F.tid]; pre += PT[512 + ch * 16 + F.tid]; } TOT[F.tid] = tot; PRE[F.tid] = pre; }
    __syncthreads();
    if (F.tid < 2) { unsigned base = 0; for (int e = 0; e < 8; ++e) { BASE[F.tid * 8 + e] = base; base += (TOT[F.tid * 8 + e] + 255u) & ~255u; } }
    __syncthreads();
    int* tok = (int*)(F.ws + OFF_TOK); float* gate = (float*)(F.ws + OFF_GATE); float* rss = (float*)(F.ws + OFF_RSS);
    if (F.tid < 16) { const int r = F.tid >> 3, e = F.tid & 7; unsigned pos = BASE[F.tid] + PRE[F.tid];
        for (int i = 0; i < per; ++i) { const f32x4 rt = RT[i]; const int ee = __float_as_int(r == 0 ? rt.x : rt.y);
            if (ee == e) { tok[r * NS + pos] = F.vcu * per + i; gate[r * NS + pos] = (r == 0) ? rt.z : rt.w; rss[r * NS + pos] = RS[i]; ++pos; } } }
    if (blockIdx.x == 0) {
        unsigned* meta = (unsigned*)(F.ws + OFF_META);
        if (F.tid < 16) { const int r = F.tid >> 3; const unsigned n = TOT[F.tid], b0 = BASE[F.tid], pe = (n + 255u) & ~255u;
            for (unsigned s = b0 + n; s < b0 + pe; ++s) { tok[r * NS + s] = -1; gate[r * NS + s] = 0.f; rss[r * NS + s] = 0.f; }
            for (unsigned tl = b0 / 256; tl < (b0 + pe) / 256; ++tl) __hip_atomic_store(meta + 16 + r * 256 + tl, (unsigned)(F.tid & 7), RLX_AGENT); }
        if (F.tid < 2) { unsigned nt = 0; for (int e = 0; e < 8; ++e) nt += (TOT[F.tid * 8 + e] + 255u) >> 8; __hip_atomic_store(meta + F.tid, nt, RLX_AGENT); }
    }
}
__device__ __forceinline__ void p_gather(Frame& F, int r) {
    const int* tok = (const int*)(F.ws + OFF_TOK) + r * NS; const bf16_t* XB = (const bf16_t*)(F.ws + WS_XB); bf16_t* AG = (bf16_t*)(F.ws + WS_AG);
    const unsigned nt = __hip_atomic_load((const unsigned*)(F.ws + OFF_META) + r, RLX_AGENT); const int nrows = (int)nt * 256;
    const int gw = F.vcu * NWAVES + F.wave, NGW = F.G * NWAVES;
    for (int s = gw; s < nrows; s += NGW) { const int tk = __hip_atomic_load(tok + s, RLX_AGENT);
        u32x4 a = (u32x4){0u, 0u, 0u, 0u}, b = a;
        if (tk >= 0) { a = *(const u32x4*)(XB + (size_t)tk * 1024 + F.lane * 8); b = *(const u32x4*)(XB + (size_t)tk * 1024 + 512 + F.lane * 8); }
        *(u32x4*)(AG + (size_t)s * 1024 + F.lane * 8) = a; *(u32x4*)(AG + (size_t)s * 1024 + 512 + F.lane * 8) = b; }
}
__device__ __forceinline__ void p_final(Frame& F) {
    const int gw = F.vcu * NWAVES + F.wave, NGW = F.G * NWAVES; const float* fn = F.in[I_FN];
    f32x4 w[4];
#pragma unroll
    for (int j = 0; j < 4; ++j) w[j] = *((const f32x4*)fn + F.lane + 64 * j);
    for (int m = gw; m < T; m += NGW) { GAS f32x4* xr = (GAS f32x4*)(F.X + (size_t)m * D) + F.lane; f32x4 v[4]; float s = 0.f;
#pragma unroll
        for (int j = 0; j < 4; ++j) { v[j] = xr[64 * j]; s += (v[j].x * v[j].x + v[j].y * v[j].y) + (v[j].z * v[j].z + v[j].w * v[j].w); }
        const float r = __builtin_amdgcn_rsqf(wave_sum(s) * (1.0f / 1024.0f) + EPS);
#pragma unroll
        for (int j = 0; j < 4; ++j) xr[64 * j] = v[j] * r * w[j]; }
}

struct Args { const float* in[18]; float* out; unsigned char* ws; int ph_lo, ph_hi; };
__global__ void __launch_bounds__(NWAVES * 64, 2) mk_fwd(Args args) {
    extern __shared__ __attribute__((aligned(16))) unsigned char lds[];
    Frame F;
    F.lds = (LAS unsigned char*)lds; F.MISC = (volatile LAS unsigned*)(F.lds + MISC_OFF);
    F.tid = threadIdx.x; F.lane = F.tid & 63; F.wave = __builtin_amdgcn_readfirstlane(F.tid >> 6);
    F.G = gridDim.x; { const int bx = blockIdx.x; F.vcu = (F.G % 8 == 0) ? (bx % 8) * (F.G / 8) + bx / 8 : bx; }
    F.ws = args.ws; F.X = args.out;
    F.in = args.in;
    unsigned* ctl = (unsigned*)(F.ws + WS_CTL);
    for (int u = F.tid; u < (LDS_BYTES - LDSCTL_OFF) / 4; u += NWAVES * 64) ((LAS unsigned*)(F.lds + LDSCTL_OFF))[u] = 0u;
    __syncthreads();
    XcdBarrier bar; bar.bar = ctl + CW_BAR; bar.x = 0; bar.st = nullptr;
    if (!MK_PER_PHASE) bar = xcd_barrier_post(ctl + CW_BAR, F.MISC + 8);
    const int lo = args.ph_lo, hi = args.ph_hi; int ph = 0;
#ifndef PH_MASK
#define PH_MASK 0xFFFFFFFFu
#endif
#define PH_ON(k) (((PH_MASK) >> (k)) & 1u)
#define PHASE_BEGIN(k) if (PH_ON(k) && ph >= lo && ph < hi) { asm volatile("" : "+v"(F.tid), "+v"(F.lane), "+s"(F.vcu), "+s"(F.ws), "+s"(F.X)); \
    bf16_t* const P = (bf16_t*)(F.ws + WS_P); bf16_t* const SB = (bf16_t*)(F.ws + WS_S); bf16_t* const XB = (bf16_t*)(F.ws + WS_XB); \
    bf16_t* const WNE = (bf16_t*)(F.ws + WS_WNE); float* const SSQ = (float*)(F.ws + OFF_SSQ); const float* const LBp = (const float*)(F.ws + OFF_LB); \
    (void)P; (void)SB; (void)XB; (void)WNE; (void)SSQ; (void)LBp;
#define PHASE_END(last) if (!MK_PER_PHASE && !(last)) xcd_barrier(bar); } ++ph;

    PHASE_BEGIN(0) p_prologue(F); PHASE_END(false)

#pragma nounroll
    for (int L = 0; L < 2; ++L) {
        PHASE_BEGIN(1)
            pg8::Gemm g{XB, WNE + WN_INA + (size_t)L * 4096 * 1024, 1024, 1024, 0, 0}; pg8::StaticOrder S; S.init(T / 256, 16, F.G, (int)blockIdx.x);
            pg8::EpiG1a E{P, SSQ + (size_t)(2 * L) * T * 4, LBp + L * 1024}; pg8::gemm_phase(F.lds, g, S, E);
        PHASE_END(false)
        PHASE_BEGIN(2) p_scan(F); PHASE_END(false)
        PHASE_BEGIN(3) p_onorm(F, L); PHASE_END(false)
        PHASE_BEGIN(4)
            pg8::Gemm g{XB, WNE + WN_INB + (size_t)L * 5120 * 1024, 1024, 1024, 0, 0}; pg8::StaticOrder S; S.init(T / 256, 20, F.G, (int)blockIdx.x);
            pg8::EpiG1b E{P, SB, SSQ + (size_t)(2 * L) * T * 4}; pg8::gemm_phase(F.lds, g, S, E);
        PHASE_END(false)
        PHASE_BEGIN(5) p_conv(F, L); PHASE_END(false)
        PHASE_BEGIN(6)
            pg8::Gemm g{P, WNE + WN_PROJ + (size_t)L * 1024 * 2048, 4096, 2048, 2048, 0}; pg8::StaticOrder S; S.init(T / 256, 4, F.G, (int)blockIdx.x);
            pg8::EpiG2 E{P, SB}; pg8::gemm_phase(F.lds, g, S, E);
        PHASE_END(false)
        PHASE_BEGIN(7)
            pg8::Gemm g{P + 1024, WNE + WN_OUT + (size_t)L * 1024 * 1024, 4096, 1024, 0, 0}; pg8::StaticOrder S; S.init(T / 256, 4, F.G, (int)blockIdx.x);
            pg8::EpiRes E{F.X, XB, SSQ + (size_t)(2 * L + 1) * T * 4, (LAS float*)(F.lds + RED_OFF)}; pg8::gemm_phase(F.lds, g, S, E);
        PHASE_END(false)
        if (L == 0) {
            PHASE_BEGIN(8)
                pg8::Gemm g{XB, WNE + WN_D13, 1024, 1024, 0, 0}; pg8::StaticOrder S; S.init(T / 256, 22, F.G, (int)blockIdx.x);
                pg8::EpiSwiglu<false> E{P, SSQ + (size_t)T * 4}; pg8::gemm_phase(F.lds, g, S, E);
            PHASE_END(false)
            PHASE_BEGIN(9)
                pg8::Gemm g{P, WNE + WN_D2, DFF, DFF, 0, 0}; pg8::StaticOrder S; S.init(T / 256, 4, F.G, (int)blockIdx.x);
                pg8::EpiRes E{F.X, XB, SSQ + (size_t)2 * T * 4, (LAS float*)(F.lds + RED_OFF)}; pg8::gemm_phase(F.lds, g, S, E);
            PHASE_END(false)
        } else {
            PHASE_BEGIN(10) p_convert_experts(F); __syncthreads(); p_route1(F); PHASE_END(false)
            PHASE_BEGIN(11) p_route2(F); PHASE_END(false)
            PHASE_BEGIN(12) p_gather(F, 0); PHASE_END(false)
#pragma nounroll
            for (int r = 0; r < 2; ++r) {
                PHASE_BEGIN(13)
                    const unsigned* meta = (const unsigned*)(F.ws + OFF_META);
                    const int nt = (int)__builtin_amdgcn_readfirstlane(__hip_atomic_load(meta + r, RLX_AGENT));
                    pg8::Gemm g{(const bf16_t*)(F.ws + WS_AG), (const bf16_t*)(F.ws + WS_WE) + WE_13, 1024, 1024, 0, (size_t)5632 * 1024}; pg8::MoeOrder S; S.so.init(nt, 22, F.G, (int)blockIdx.x); S.tile_e = meta + 16 + r * 256;
                    pg8::EpiSwiglu<true> E{(bf16_t*)(F.ws + WS_H), (const float*)(F.ws + OFF_RSS) + r * NS}; pg8::gemm_phase(F.lds, g, S, E);
                PHASE_END(false)
                PHASE_BEGIN(14)
                    if (r == 0) p_gather(F, 1);
                    const unsigned* meta = (const unsigned*)(F.ws + OFF_META);
                    const int nt = (int)__builtin_amdgcn_readfirstlane(__hip_atomic_load(meta + r, RLX_AGENT));
                    pg8::Gemm g{(const bf16_t*)(F.ws + WS_H), (const bf16_t*)(F.ws + WS_WE) + WE_2, DFF, DFF, 0, (size_t)1024 * DFF}; pg8::MoeOrder S; S.so.init(nt, 4, F.G, (int)blockIdx.x); S.tile_e = meta + 16 + r * 256;
                    pg8::EpiDown E{F.X, (const int*)(F.ws + OFF_TOK) + r * NS, (const float*)(F.ws + OFF_GATE) + r * NS}; pg8::gemm_phase(F.lds, g, S, E);
                PHASE_END(false)
            }
        }
    }
    PHASE_BEGIN(15) p_final(F); PHASE_END(true)
}
constexpr int N_PHASES = 1 + 7 + 2 + 7 + 3 + 4 + 1;

extern "C" void kernel_launch(void* const* d_in, const int* in_sizes, int n_in, void* d_out, int out_size, void* d_ws, size_t ws_size, hipStream_t stream) {
    static int grid = 0;
    if (grid == 0) {
        if (n_in != 18 || in_sizes[0] != T * D || out_size != T * D || ws_size < WS_END) { fprintf(stderr, "kernel_launch: unexpected shapes / workspace (n_in %d, ws %zu, need %zu); nothing launched\n", n_in, ws_size, (size_t)WS_END); grid = -1; return; }
        int dev = 0, cus = 0, per_cu = 0;
        if (hipGetDevice(&dev) != hipSuccess || hipDeviceGetAttribute(&cus, hipDeviceAttributeMultiprocessorCount, dev) != hipSuccess) { grid = -1; return; }
        if (hipFuncSetAttribute((const void*)mk_fwd, hipFuncAttributeMaxDynamicSharedMemorySize, LDS_BYTES) != hipSuccess) { fprintf(stderr, "kernel_launch: hipFuncSetAttribute failed\n"); grid = -1; return; }
        if (hipOccupancyMaxActiveBlocksPerMultiprocessor(&per_cu, (const void*)mk_fwd, NWAVES * 64, LDS_BYTES) != hipSuccess || per_cu < 1) { fprintf(stderr, "kernel_launch: occupancy query says %d\n", per_cu); }
        (void)hipGetLastError();
        grid = cus;
    }
    if (grid < 0) return;
    if (hipMemsetAsync((char*)d_ws + WS_CTL, 0, ZERO_BYTES, stream) != hipSuccess) return;
    Args a{};
    for (int i = 0; i < 18; ++i) a.in[i] = (const float*)d_in[i];
    a.out = (float*)d_out; a.ws = (unsigned char*)d_ws;
#if MK_PER_PHASE
    for (int p = 0; p < N_PHASES; ++p) { a.ph_lo = p; a.ph_hi = p + 1; hipLaunchKernelGGL(mk_fwd, dim3(grid), dim3(NWAVES * 64), LDS_BYTES, stream, a); }
#else
    a.ph_lo = 0; a.ph_hi = N_PHASES; hipLaunchKernelGGL(mk_fwd, dim3(grid), dim3(NWAVES * 64), LDS_BYTES, stream, a);
#endif
}
```

```cpp
#include <hip/hip_runtime.h>
#include <cstdio>
#include <cstdint>

#ifndef USE_NAIVE_SCAN
#define USE_NAIVE_SCAN 0
#endif
#ifndef MK_PER_PHASE
#define MK_PER_PHASE 0
#endif

#define LAS __attribute__((address_space(3)))
#define GAS __attribute__((address_space(1)))
typedef unsigned short bf16_t;
typedef short bf16x8 __attribute__((ext_vector_type(8)));
typedef float f32x4 __attribute__((ext_vector_type(4)));
typedef float f32x2 __attribute__((ext_vector_type(2)));
typedef unsigned u32x4 __attribute__((ext_vector_type(4)));
typedef unsigned u32x2 __attribute__((ext_vector_type(2)));
#define RLX_AGENT __ATOMIC_RELAXED, __HIP_MEMORY_SCOPE_AGENT

constexpr int D = 1024, BATCH = 4, SEQ = 8192, T = BATCH * SEQ, NH = 8, HK = 128, HV = 128;
constexpr int DFF = 2816, NE = 8, INW = 9216;
constexpr float EPS = 1e-6f, QSCALE = 0.08838834764831845f;
constexpr int NS = T + NE * 256;
constexpr int NSTILE = NS / 256;

constexpr size_t MiB = 1u << 20;
constexpr size_t WS_CTL = 0;
constexpr size_t ZERO_BYTES = 65536;
constexpr size_t OFF_SSQ = 65536;
constexpr size_t OFF_LB = OFF_SSQ + (size_t)4 * T * 16;
constexpr size_t OFF_BLKCNT = OFF_LB + 8192;
constexpr size_t OFF_META = OFF_BLKCNT + 16384;
constexpr size_t OFF_ROUTE = OFF_META + 4096;
constexpr size_t OFF_DEC = OFF_ROUTE;
constexpr size_t OFF_TOK = OFF_ROUTE + (size_t)T * 16;
constexpr size_t OFF_GATE = OFF_TOK + (size_t)2 * NS * 4;
constexpr size_t OFF_RSS = OFF_GATE + (size_t)2 * NS * 4;
static_assert(OFF_RSS + (size_t)2 * NS * 4 <= 4 * MiB && OFF_DEC + (size_t)2048 * 128 * 4 <= 4 * MiB, "ctl region");
constexpr size_t WS_XB = 4 * MiB;
constexpr size_t WS_P = 68 * MiB;
constexpr size_t WS_S = 324 * MiB;
constexpr size_t WS_WNE = 388 * MiB;
constexpr size_t WS_WE = 388 * MiB;
constexpr size_t WS_END = 520 * MiB;
constexpr size_t WN_INA = 0;
constexpr size_t WN_INB = WN_INA + (size_t)2 * 4096 * 1024;
constexpr size_t WN_PROJ = WN_INB + (size_t)2 * 5120 * 1024;
constexpr size_t WN_OUT = WN_PROJ + (size_t)2 * 1024 * 2048;
constexpr size_t WN_D13 = WN_OUT + (size_t)2 * 1024 * 1024;
constexpr size_t WN_D2 = WN_D13 + (size_t)5632 * 1024;
constexpr size_t WN_END = WN_D2 + (size_t)1024 * 2816;
static_assert(WN_END * 2 <= 65 * MiB, "wne");
constexpr size_t WE_13 = 0;
constexpr size_t WE_2 = (size_t)8 * 5632 * 1024;
static_assert((WE_2 + (size_t)8 * 1024 * 2816) * 2 <= WS_END - WS_WE, "we");
constexpr size_t WS_H = WS_P;
constexpr size_t WS_AG = WS_P + 188 * MiB;
static_assert((size_t)NS * 2816 * 2 <= 188 * MiB && WS_AG + (size_t)NS * 2048 <= WS_S + 64 * MiB, "moe map");

constexpr int CW_TMO = 0, CW_CODE = 1, CW_BAR = 4096;

constexpr int RING_BYTES = 131072;
constexpr int LDSCTL_OFF = RING_BYTES, MISC_OFF = LDSCTL_OFF + 320, RED_OFF = LDSCTL_OFF + 2048;
constexpr int RSCR_OFF = LDSCTL_OFF + 8192;
constexpr int LDS_BYTES = 147456;
constexpr int NWAVES = 8;

namespace pg8 {
constexpr int BM = 256, BK = 64, HALF = 128, HTB = HALF * BK * 2, STAGE_BYTES = 8 * HTB, NXCD = 8, WGM = 8;
__host__ __device__ __forceinline__ int lds_byte(int r, int c) { const int st = (r >> 4) * 2 + (c >> 5), rr = r & 15, cc = c & 31, ob = rr * 64 + cc * 2; return st * 1024 + (ob ^ (((ob >> 9) & 1) << 5)); }
__host__ __device__ __forceinline__ void stage_rc(int b, int& R, int& C) { const int st = b / 1024, sb = b % 1024, swz = sb ^ (((sb >> 9) & 1) << 5); R = (st >> 1) * 16 + swz / 64; C = (st & 1) * 32 + (swz % 64) / 2; }
__host__ __device__ __forceinline__ int perm32(int rho) { const int n = rho >> 4, i = rho & 15; return 8 * (i >> 2) + 4 * n + (i & 3); }

struct Unit { int pm, pn, e; };
struct Gemm { const bf16_t* A; const bf16_t* Bt; int lda; int K; int a_jump; size_t b_estride; };

struct StaticOrder {
    int nM, nN, nwg, G, c;
    __device__ void init(int nM_, int nN_, int G_, int c_) { nM = nM_; nN = nN_; nwg = nM * nN; G = G_; c = c_; }
    __device__ bool next(int i, Unit& u) const {
        const long L = (long)i * G + c; if (L >= nwg) return false;
        int wgid = (int)L; { const int q = nwg / NXCD, r = nwg % NXCD, xcd = wgid % NXCD, off = wgid / NXCD; wgid = (xcd < r ? xcd * (q + 1) : r * (q + 1) + (xcd - r) * q) + off; }
        const int nig = WGM * nN, gid = wgid / nig, fm = gid * WGM, gsz = (nM - fm) < WGM ? (nM - fm) : WGM;
        u.pm = fm + ((wgid % nig) % gsz); u.pn = (wgid % nig) / gsz; u.e = 0; return true;
    }
};
struct MoeOrder {
    StaticOrder so; const unsigned* tile_e;
    __device__ bool next(int i, Unit& u) const {
        if (!so.next(i, u)) return false;
        u.e = (int)__builtin_amdgcn_readfirstlane(__hip_atomic_load(tile_e + u.pm, RLX_AGENT)); return true;
    }
};

__device__ __forceinline__ unsigned cvt_pk_bf16(float lo, float hi) { unsigned r; asm volatile("v_cvt_pk_bf16_f32 %0, %1, %2" : "=v"(r) : "v"(lo), "v"(hi)); return r; }
__device__ __forceinline__ float bf_lo(unsigned w) { return __uint_as_float(w << 16); }
__device__ __forceinline__ float bf_hi(unsigned w) { return __uint_as_float(w & 0xffff0000u); }
__device__ __forceinline__ float sigmoidf_(float v) { return __builtin_amdgcn_rcpf(1.0f + __expf(-v)); }
__device__ __forceinline__ float siluf_(float v) { return v * sigmoidf_(v); }

typedef f32x4 Acc[2][2][4][2];

template <class Epi, class Sched>
__device__ __forceinline__ void gemm_phase(LAS unsigned char* lds, const Gemm g, const Sched& S, const Epi& E) {
    int tid_ = threadIdx.x; asm volatile("" : "+v"(tid_));
    const int tid = tid_, wid = __builtin_amdgcn_readfirstlane(tid >> 6), lane = tid & 63, wr = wid >> 2, wc = wid & 3, fr = lane & 15, fq = lane >> 4;
    const int K = g.K, nt = K / BK, th = nt / 2;
    unsigned voffA[2], voffB[2];
#pragma unroll
    for (int i = 0; i < 2; ++i) { int R, C; stage_rc(tid * 16 + i * 8192, R, C); const int Rb = (R & ~31) + perm32(R & 31);
        voffA[i] = (unsigned)(R * g.lda + C) * 2u; voffB[i] = (unsigned)(Rb * K + C) * 2u; }
    const size_t kstep = (size_t)(BK * 2);
    const size_t hstepA = (size_t)HALF * g.lda * 2, tstepA = 2 * hstepA;
    const size_t hstepB = (size_t)HALF * K * 2, tstepB = 2 * hstepB;
    const size_t jump = (size_t)g.a_jump;
    const unsigned ldsw = (unsigned)wid * 1024u;
    const int aoff = lds_byte(wr * 64 + fr, fq * 8), boff = lds_byte(wc * 32 + fr, fq * 8);
#define PG8_KA(tt) ((size_t)(tt) * kstep + (((tt) >= th) ? jump : (size_t)0))
#define PG8_SA(b, h) (((b) * 2 + (h)) * HTB)
#define PG8_SB(b, h) ((4 + (b) * 2 + (h)) * HTB)
#define PG8_STAGE(bufoff, gbase, voff) do { _Pragma("unroll") for (int _i = 0; _i < 2; ++_i) \
        __builtin_amdgcn_global_load_lds((const unsigned*)((const char*)(gbase) + (voff)[_i]), (LAS unsigned*)(lds + (bufoff) + ldsw + _i * 8192), 16, 0, 0); } while (0)
#define PG8_LDA(dst, b, h) do { _Pragma("unroll") for (int m = 0; m < 4; ++m) _Pragma("unroll") for (int k = 0; k < 2; ++k) dst[m][k] = *(const LAS bf16x8*)(lds + PG8_SA(b, h) + aoff + m * 2048 + k * 1024); } while (0)
#define PG8_LDB(dst, b, h) do { _Pragma("unroll") for (int n = 0; n < 2; ++n) _Pragma("unroll") for (int k = 0; k < 2; ++k) dst[n][k] = *(const LAS bf16x8*)(lds + PG8_SB(b, h) + boff + n * 2048 + k * 1024); } while (0)
#define PG8_MMA(ai, bj, At, Bt) do { __builtin_amdgcn_s_setprio(1); _Pragma("unroll") for (int m = 0; m < 4; ++m) _Pragma("unroll") for (int n = 0; n < 2; ++n) _Pragma("unroll") for (int k = 0; k < 2; ++k) \
        acc[ai][bj][m][n] = __builtin_amdgcn_mfma_f32_16x16x32_bf16(Bt[n][k], At[m][k], acc[ai][bj][m][n], 0, 0, 0); __builtin_amdgcn_s_setprio(0); } while (0)
#define PG8_WAIT_V(n) asm volatile("s_waitcnt vmcnt(" #n ")" ::: "memory")
#define PG8_WAIT_L(n) asm volatile("s_waitcnt lgkmcnt(" #n ")" ::: "memory")
#define PG8_BAR __builtin_amdgcn_s_barrier()
#define PG8_SCHED __builtin_amdgcn_sched_barrier(0)
    Unit cur, nxt; int ui = 0;
    if (!S.next(0, cur)) return;
    Acc acc;
#pragma unroll
    for (int a = 0; a < 2; ++a)
#pragma unroll
        for (int b = 0; b < 2; ++b)
#pragma unroll
            for (int m = 0; m < 4; ++m)
#pragma unroll
                for (int n = 0; n < 2; ++n) acc[a][b][m][n] = (f32x4){0.f, 0.f, 0.f, 0.f};
    bf16x8 At[4][2], B0[2][2], B1[2][2];
    const char* cA = (const char*)g.A + (size_t)cur.pm * tstepA; const char* cB = (const char*)g.Bt + ((size_t)cur.e * g.b_estride) * 2 + (size_t)cur.pn * tstepB;
    PG8_STAGE(PG8_SB(0, 0), cB, voffB); PG8_STAGE(PG8_SB(0, 1), cB + hstepB, voffB); PG8_STAGE(PG8_SA(0, 0), cA, voffA); PG8_STAGE(PG8_SA(0, 1), cA + hstepA, voffA);
    if (wr == 1) PG8_BAR;
    PG8_WAIT_V(2); PG8_BAR;
    PG8_STAGE(PG8_SB(1, 0), cB + kstep, voffB); PG8_STAGE(PG8_SA(1, 0), cA + PG8_KA(1), voffA); PG8_STAGE(PG8_SB(1, 1), cB + hstepB + kstep, voffB);
    PG8_WAIT_V(6); PG8_BAR;
    for (;;) {
        const bool has_next = S.next(ui + 1, nxt);
        const char* nA = has_next ? (const char*)g.A + (size_t)nxt.pm * tstepA : cA; const char* nB = has_next ? (const char*)g.Bt + ((size_t)nxt.e * g.b_estride) * 2 + (size_t)nxt.pn * tstepB : cB;
        for (int t = 0; t < nt; t += 2) {
            const bool last = (t == nt - 2);
            const char* a1 = cA + PG8_KA(t + 1);
            const char* a2 = last ? nA : cA + PG8_KA(t + 2); const char* b2 = last ? nB : cB + (size_t)(t + 2) * kstep;
            const char* a3 = last ? nA + PG8_KA(1) : cA + PG8_KA(t + 3); const char* b3 = b2 + kstep;
            if constexpr (Epi::HAS_MID) { if (t == th) E.mid(acc, cur, wr, wc, fr, fq); }
            PG8_LDB(B0, 0, 0); PG8_LDB(B1, 0, 1); PG8_SCHED; PG8_LDA(At, 0, 0); PG8_STAGE(PG8_SA(1, 1), a1 + hstepA, voffA);
            PG8_WAIT_V(8); PG8_WAIT_L(0); PG8_BAR; PG8_MMA(0, 0, At, B0); PG8_MMA(0, 1, At, B1); PG8_BAR; PG8_SCHED;
            PG8_LDA(At, 0, 1); PG8_STAGE(PG8_SB(0, 0), b2, voffB); PG8_STAGE(PG8_SB(0, 1), b2 + hstepB, voffB); PG8_STAGE(PG8_SA(0, 0), a2, voffA);
            PG8_WAIT_V(8); PG8_WAIT_L(0); PG8_BAR; PG8_MMA(1, 0, At, B0); PG8_MMA(1, 1, At, B1); PG8_BAR; PG8_SCHED;
            PG8_LDB(B0, 1, 0); PG8_LDB(B1, 1, 1); PG8_SCHED; PG8_LDA(At, 1, 0); PG8_STAGE(PG8_SA(0, 1), a2 + hstepA, voffA);
            PG8_WAIT_V(8); PG8_WAIT_L(0); PG8_BAR; PG8_MMA(0, 0, At, B0); PG8_MMA(0, 1, At, B1); PG8_BAR; PG8_SCHED;
            PG8_LDA(At, 1, 1); PG8_STAGE(PG8_SB(1, 0), b3, voffB); PG8_STAGE(PG8_SB(1, 1), b3 + hstepB, voffB); PG8_STAGE(PG8_SA(1, 0), a3, voffA);
            PG8_WAIT_V(8); PG8_WAIT_L(0); PG8_BAR; PG8_MMA(1, 0, At, B0); PG8_MMA(1, 1, At, B1); PG8_BAR; PG8_SCHED;
        }
        if (wr == 0) PG8_BAR;
        E(acc, cur, wr, wc, fr, fq);
        if (!has_next) break;
#pragma unroll
        for (int a = 0; a < 2; ++a)
#pragma unroll
            for (int b = 0; b < 2; ++b)
#pragma unroll
                for (int m = 0; m < 4; ++m)
#pragma unroll
                    for (int n = 0; n < 2; ++n) acc[a][b][m][n] = (f32x4){0.f, 0.f, 0.f, 0.f};
        cur = nxt; cA = nA; cB = nB; ++ui;
        if (wr == 1) PG8_BAR;
    }
    PG8_WAIT_V(0);
    PG8_BAR;
#undef PG8_KA
#undef PG8_SA
#undef PG8_SB
#undef PG8_STAGE
#undef PG8_LDA
#undef PG8_LDB
#undef PG8_MMA
#undef PG8_WAIT_V
#undef PG8_WAIT_L
#undef PG8_BAR
#undef PG8_SCHED
}

__device__ __forceinline__ void load_rstd(const float* ssq, int row0, float (&rs)[2][4]) {
#pragma unroll
    for (int ai = 0; ai < 2; ++ai)
#pragma unroll
        for (int m = 0; m < 4; ++m) { const f32x4 p = *(const f32x4*)(ssq + (size_t)(row0 + ai * HALF + m * 16) * 4); rs[ai][m] = __builtin_amdgcn_rsqf(((p.x + p.y) + (p.z + p.w)) * (1.0f / 1024.0f) + EPS); }
}
__device__ __forceinline__ float rstd_of(const float* ssq, int row) { const f32x4 p = *(const f32x4*)(ssq + (size_t)row * 4); return __builtin_amdgcn_rsqf(((p.x + p.y) + (p.z + p.w)) * (1.0f / 1024.0f) + EPS); }
__device__ __forceinline__ u32x4 pack8(const f32x4 v0, const f32x4 v1) { u32x4 w; w.x = cvt_pk_bf16(v0[0], v0[1]); w.y = cvt_pk_bf16(v0[2], v0[3]); w.z = cvt_pk_bf16(v1[0], v1[1]); w.w = cvt_pk_bf16(v1[2], v1[3]); return w; }

struct EpiG1a {
    static constexpr bool HAS_MID = false;
    bf16_t* P; const float* ssq; const float* LB;
    __device__ __forceinline__ void operator()(const Acc& acc, const Unit& u, int wr, int wc, int fr_, int fq_) const {
        int fr = fr_, fq = fq_; asm volatile("" : "+v"(fr), "+v"(fq));
        const int grp = u.pn >> 2, row0 = u.pm * BM + wr * 64 + fr, col0 = u.pn * BM + wc * 32 + 8 * fq;
        float rs[2][4]; load_rstd(ssq, row0, rs);
        if (grp == 1) {
            f32x4 lb[2][2];
#pragma unroll
            for (int bj = 0; bj < 2; ++bj)
#pragma unroll
                for (int n = 0; n < 2; ++n) lb[bj][n] = *(const f32x4*)(LB + (col0 - 1024) + bj * HALF + 4 * n);
#pragma unroll
            for (int ai = 0; ai < 2; ++ai)
#pragma unroll
                for (int m = 0; m < 4; ++m) { bf16_t* rowp = P + (size_t)(row0 + ai * HALF + m * 16) * 4096 + col0; const float r = rs[ai][m];
#pragma unroll
                    for (int bj = 0; bj < 2; ++bj) { f32x4 o[2];
#pragma unroll
                        for (int n = 0; n < 2; ++n)
#pragma unroll
                            for (int j = 0; j < 4; ++j) { const float z = acc[ai][bj][m][n][j] * r, l = lb[bj][n][j]; const float f = l + (1.0f - l) * sigmoidf_(z); o[n][j] = __logf(fmaxf(f, 1e-6f)); }
                        *(u32x4*)(rowp + bj * HALF) = pack8(o[0], o[1]); } }
        } else {
#pragma unroll
            for (int ai = 0; ai < 2; ++ai)
#pragma unroll
                for (int m = 0; m < 4; ++m) { bf16_t* rowp = P + (size_t)(row0 + ai * HALF + m * 16) * 4096 + col0; const float r = rs[ai][m];
#pragma unroll
                    for (int bj = 0; bj < 2; ++bj) { f32x4 o[2];
#pragma unroll
                        for (int n = 0; n < 2; ++n)
#pragma unroll
                            for (int j = 0; j < 4; ++j) { const float z = acc[ai][bj][m][n][j] * r; o[n][j] = (grp == 0) ? siluf_(z) * QSCALE : (grp == 3) ? siluf_(z) : z; }
                        *(u32x4*)(rowp + bj * HALF) = pack8(o[0], o[1]); } }
        }
    }
};
struct EpiG1b {
    static constexpr bool HAS_MID = false;
    bf16_t* P; bf16_t* SB; const float* ssq;
    __device__ __forceinline__ void operator()(const Acc& acc, const Unit& u, int wr, int wc, int fr_, int fq_) const {
        int fr = fr_, fq = fq_; asm volatile("" : "+v"(fr), "+v"(fq));
        const int row0 = u.pm * BM + wr * 64 + fr, cw = wc * 32 + 8 * fq;
        float rs[2][4]; load_rstd(ssq, row0, rs);
        if (u.pn < 8) {
#pragma unroll
            for (int ai = 0; ai < 2; ++ai)
#pragma unroll
                for (int m = 0; m < 4; ++m) { const float r2 = rs[ai][m] * rs[ai][m]; f32x4 o[2];
#pragma unroll
                    for (int n = 0; n < 2; ++n) o[n] = acc[ai][0][m][n] * acc[ai][1][m][n] * r2;
                    *(u32x4*)(P + (size_t)(row0 + ai * HALF + m * 16) * 4096 + 1024 + u.pn * HALF + cw) = pack8(o[0], o[1]); }
        } else {
            const int t = u.pn - 8, grp = t >> 2;
            bf16_t* base = (grp == 2) ? SB : P + 2048 + grp * 1024; const size_t ld = (grp == 2) ? 1024 : 4096; const int col0 = (t & 3) * BM + cw;
#pragma unroll
            for (int ai = 0; ai < 2; ++ai)
#pragma unroll
                for (int m = 0; m < 4; ++m) { bf16_t* rowp = base + (size_t)(row0 + ai * HALF + m * 16) * ld + col0; const float r = rs[ai][m];
#pragma unroll
                    for (int bj = 0; bj < 2; ++bj) { f32x4 o[2];
#pragma unroll
                        for (int n = 0; n < 2; ++n)
#pragma unroll
                            for (int j = 0; j < 4; ++j) { const float z = acc[ai][bj][m][n][j] * r; o[n][j] = (grp == 0) ? z : sigmoidf_(z); }
                        *(u32x4*)(rowp + bj * HALF) = pack8(o[0], o[1]); } }
        }
    }
};
struct EpiG2 {
    static constexpr bool HAS_MID = true;
    bf16_t* P; const bf16_t* SB;
    __device__ __forceinline__ void mid(Acc& acc, const Unit& u, int wr, int wc, int fr_, int fq_) const {
        int fr = fr_, fq = fq_; asm volatile("" : "+v"(fr), "+v"(fq));
        const int row0 = u.pm * BM + wr * 64 + fr, col0 = u.pn * BM + wc * 32 + 8 * fq;
#pragma unroll
        for (int ai = 0; ai < 2; ++ai)
#pragma unroll
            for (int m = 0; m < 4; ++m) { const size_t row = (size_t)(row0 + ai * HALF + m * 16);
#pragma unroll
                for (int bj = 0; bj < 2; ++bj) { const u32x4 a = *(const u32x4*)(P + row * 4096 + 3072 + col0 + bj * HALF), b = *(const u32x4*)(SB + row * 1024 + col0 + bj * HALF);
#pragma unroll
                    for (int q = 0; q < 4; ++q) { const float r0 = bf_lo(a[q]) * __builtin_amdgcn_rcpf(fmaxf(bf_lo(b[q]), 1e-20f)), r1 = bf_hi(a[q]) * __builtin_amdgcn_rcpf(fmaxf(bf_hi(b[q]), 1e-20f));
                        acc[ai][bj][m][q >> 1][(q & 1) * 2] *= r0; acc[ai][bj][m][q >> 1][(q & 1) * 2 + 1] *= r1; } }
                asm volatile("" ::: "memory"); }
    }
    __device__ __forceinline__ void operator()(const Acc& acc, const Unit& u, int wr, int wc, int fr_, int fq_) const {
        int fr = fr_, fq = fq_; asm volatile("" : "+v"(fr), "+v"(fq));
        const int row0 = u.pm * BM + wr * 64 + fr, col0 = u.pn * BM + wc * 32 + 8 * fq;
#pragma unroll
        for (int ai = 0; ai < 2; ++ai)
#pragma unroll
            for (int m = 0; m < 4; ++m) { const size_t row = (size_t)(row0 + ai * HALF + m * 16);
#pragma unroll
                for (int bj = 0; bj < 2; ++bj) { const u32x4 b = *(const u32x4*)(SB + row * 1024 + col0 + bj * HALF); f32x4 o[2];
#pragma unroll
                    for (int q = 0; q < 4; ++q) { o[q >> 1][(q & 1) * 2] = acc[ai][bj][m][q >> 1][(q & 1) * 2] * bf_lo(b[q]); o[q >> 1][(q & 1) * 2 + 1] = acc[ai][bj][m][q >> 1][(q & 1) * 2 + 1] * bf_hi(b[q]); }
                    *(u32x4*)(P + row * 4096 + 1024 + col0 + bj * HALF) = pack8(o[0], o[1]); }
                asm volatile("" ::: "memory"); }
    }
};
struct EpiRes {
    static constexpr bool HAS_MID = false;
    float* X; bf16_t* XB; float* ssq_out; LAS float* red;
    __device__ __forceinline__ void operator()(const Acc& acc, const Unit& u, int wr, int wc, int fr_, int fq_) const {
        int fr = fr_, fq = fq_; asm volatile("" : "+v"(fr), "+v"(fq));
        const int row0 = u.pm * BM + wr * 64 + fr, col0 = u.pn * BM + wc * 32 + 8 * fq;
#pragma unroll
        for (int ai = 0; ai < 2; ++ai)
#pragma unroll
            for (int m = 0; m < 4; ++m) { const size_t row = (size_t)(row0 + ai * HALF + m * 16); float* xr = X + row * 1024 + col0; float s = 0.f;
#pragma unroll
                for (int bj = 0; bj < 2; ++bj) { f32x4 v0 = *(const f32x4*)(xr + bj * HALF) + acc[ai][bj][m][0], v1 = *(const f32x4*)(xr + bj * HALF + 4) + acc[ai][bj][m][1];
                    *(f32x4*)(xr + bj * HALF) = v0; *(f32x4*)(xr + bj * HALF + 4) = v1; *(u32x4*)(XB + row * 1024 + col0 + bj * HALF) = pack8(v0, v1);
                    s += (v0[0] * v0[0] + v0[1] * v0[1]) + (v0[2] * v0[2] + v0[3] * v0[3]) + (v1[0] * v1[0] + v1[1] * v1[1]) + (v1[2] * v1[2] + v1[3] * v1[3]); }
                s += __shfl_xor(s, 16); s += __shfl_xor(s, 32);
                if (fq == 0) red[(ai * HALF + wr * 64 + m * 16 + fr) * 4 + wc] = s;
                asm volatile("" ::: "memory"); }
        asm volatile("s_waitcnt lgkmcnt(0)" ::: "memory"); __builtin_amdgcn_s_barrier(); asm volatile("" ::: "memory");
        const int t = threadIdx.x;
        if (t < 256) { const f32x4 p = *(const LAS f32x4*)(red + t * 4); ssq_out[(size_t)(u.pm * BM + t) * 4 + u.pn] = (p.x + p.y) + (p.z + p.w); }
    }
};
template <bool SLOT> struct EpiSwiglu {
    static constexpr bool HAS_MID = false;
    bf16_t* H; const float* rsrc;
    __device__ __forceinline__ void operator()(const Acc& acc, const Unit& u, int wr, int wc, int fr_, int fq_) const {
        int fr = fr_, fq = fq_; asm volatile("" : "+v"(fr), "+v"(fq));
        const int row0 = u.pm * BM + wr * 64 + fr, col0 = u.pn * HALF + wc * 32 + 8 * fq;
        float rs[2][4];
        if constexpr (SLOT) {
#pragma unroll
            for (int ai = 0; ai < 2; ++ai)
#pragma unroll
                for (int m = 0; m < 4; ++m) rs[ai][m] = __hip_atomic_load(rsrc + row0 + ai * HALF + m * 16, RLX_AGENT);
        } else load_rstd(rsrc, row0, rs);
#pragma unroll
        for (int ai = 0; ai < 2; ++ai)
#pragma unroll
            for (int m = 0; m < 4; ++m) { const float r = rs[ai][m]; f32x4 o[2];
#pragma unroll
                for (int n = 0; n < 2; ++n)
#pragma unroll
                    for (int j = 0; j < 4; ++j) o[n][j] = siluf_(acc[ai][0][m][n][j] * r) * (acc[ai][1][m][n][j] * r);
                *(u32x4*)(H + (size_t)(row0 + ai * HALF + m * 16) * DFF + col0) = pack8(o[0], o[1]); }
    }
};
struct EpiDown {
    static constexpr bool HAS_MID = false;
    float* X; const int* tok; const float* gate;
    __device__ __forceinline__ void operator()(const Acc& acc, const Unit& u, int wr, int wc, int fr_, int fq_) const {
        int fr = fr_, fq = fq_; asm volatile("" : "+v"(fr), "+v"(fq));
        const int row0 = u.pm * BM + wr * 64 + fr, col0 = u.pn * BM + wc * 32 + 8 * fq;
#pragma unroll
        for (int ai = 0; ai < 2; ++ai)
#pragma unroll
            for (int m = 0; m < 4; ++m) { const int row = row0 + ai * HALF + m * 16; const int tk = __hip_atomic_load(tok + row, RLX_AGENT); const float gt = __hip_atomic_load(gate + row, RLX_AGENT);
                if (tk >= 0) { float* xr = X + (size_t)tk * 1024 + col0;
#pragma unroll
                    for (int bj = 0; bj < 2; ++bj) { const f32x4 v0 = *(const f32x4*)(xr + bj * HALF) + acc[ai][bj][m][0] * gt, v1 = *(const f32x4*)(xr + bj * HALF + 4) + acc[ai][bj][m][1] * gt;
                        *(f32x4*)(xr + bj * HALF) = v0; *(f32x4*)(xr + bj * HALF + 4) = v1; } }
                asm volatile("" ::: "memory"); }
    }
};
}

#define XB_TMO      128
#define XB_XCNT(j)  (256  + 64 * (j))
#define XB_XSUB(j)  (1280 + 64 * (j))
#define XB_XGEN(j)  (2304 + 64 * (j))
#define XB_TOP      3328
#define XB_TOPGEN   3392
#define XCD_BAR_WORDS 3456
#define XB_SPIN_CAP (1u << 18)
__device__ __forceinline__ unsigned xb_ld(unsigned* p)              { return __hip_atomic_load(p, __ATOMIC_RELAXED, __HIP_MEMORY_SCOPE_AGENT); }
__device__ __forceinline__ unsigned xb_add(unsigned* p, unsigned v) { return __hip_atomic_fetch_add(p, v, __ATOMIC_RELAXED, __HIP_MEMORY_SCOPE_AGENT); }
__device__ __forceinline__ unsigned xb_xcc_id() { return (unsigned)__builtin_amdgcn_s_getreg((3 << 11) | 20) & 0xFu; }
#define XB_SPIN(cond, bar) do { unsigned _sp = 0; while (cond) { __builtin_amdgcn_s_sleep(1); \
    if ((++_sp & 255u) == 0u) { if (xb_ld(&(bar)[XB_TMO])) break; if (_sp > XB_SPIN_CAP) { atomicAdd(&(bar)[XB_TMO], 1u); break; } } } } while (0)
struct XcdBarrier { unsigned* bar; unsigned x; volatile LAS unsigned* st; };
__device__ __forceinline__ XcdBarrier xcd_barrier_post(unsigned* bar, volatile LAS unsigned* st) {
    XcdBarrier b; b.bar = bar; b.x = xb_xcc_id(); b.st = st;
    if (threadIdx.x == 0) (void)xb_add(&bar[XB_XCNT(b.x)], 1u);
    return b;
}
__device__ __forceinline__ void xcd_barrier_complete(unsigned* bar, unsigned x, unsigned& nloc, unsigned& nx) {
    const unsigned G = gridDim.x * gridDim.y * gridDim.z;
    unsigned sum, cnt, mine, sp = 0u;
    for (;;) {
        sum = 0u; cnt = 0u; mine = 0u;
#pragma unroll
        for (unsigned j = 0; j < 16; ++j) { const unsigned c = xb_ld(&bar[XB_XCNT(j)]); sum += c; cnt += (c > 0u) ? 1u : 0u; mine = (j == x) ? c : mine; }
        if (sum == G) break;
        __builtin_amdgcn_s_sleep(1);
        if ((++sp & 255u) == 0u) { if (xb_ld(&bar[XB_TMO])) break; if (sp > XB_SPIN_CAP) { atomicAdd(&bar[XB_TMO], 1u); break; } }
    }
    nloc = mine > 0u ? mine : 1u; nx = cnt > 0u ? cnt : 1u;
}
__device__ __forceinline__ void xcd_barrier(const XcdBarrier& b) {
    asm volatile("s_waitcnt vmcnt(0)" ::: "memory");
    __syncthreads();
    if (threadIdx.x == 0) {
        unsigned* bar = b.bar;
        __builtin_amdgcn_s_waitcnt(0);
        unsigned nloc = b.st[0], nx = b.st[1];
        if (nloc == 0u) { xcd_barrier_complete(bar, b.x, nloc, nx); b.st[0] = nloc; b.st[1] = nx; }
        const unsigned old = xb_add(&bar[XB_XSUB(b.x)], 1u);
        const unsigned gen = old / nloc;
        if (old + 1u == (gen + 1u) * nloc) {
            __builtin_amdgcn_fence(__ATOMIC_RELEASE, "agent");
            asm volatile("s_waitcnt vmcnt(0)" ::: "memory");
            const unsigned og = xb_add(&bar[XB_TOP], 1u);
            const unsigned tg = og / nx;
            if (og + 1u == (tg + 1u) * nx) xb_add(&bar[XB_TOPGEN], 1u);
            else XB_SPIN(xb_ld(&bar[XB_TOPGEN]) == tg, bar);
            __builtin_amdgcn_fence(__ATOMIC_ACQUIRE, "agent");
            xb_add(&bar[XB_XGEN(b.x)], 1u);
            asm volatile("s_waitcnt vmcnt(0)" ::: "memory");
        } else {
            XB_SPIN(xb_ld(&bar[XB_XGEN(b.x)]) == gen, bar);
            __builtin_amdgcn_fence(__ATOMIC_ACQUIRE, "agent");
            asm volatile("s_waitcnt vmcnt(0)" ::: "memory");
        }
    }
    __syncthreads();
}

struct Frame {
    LAS unsigned char* lds; volatile LAS unsigned* MISC;
    int tid, lane, wave, vcu, G, rot;
    unsigned char* ws; float* X;
    const float* const* in;
};
#define LDS_WAIT() asm volatile("s_waitcnt lgkmcnt(0)" ::: "memory")
__device__ __forceinline__ float wave_sum(float v) {
#pragma unroll
    for (int o = 1; o < 64; o <<= 1) v += __shfl_xor(v, o);
    return v;
}
__device__ __forceinline__ unsigned f2bf(float f) { unsigned u = __builtin_bit_cast(unsigned, f); return (u + 0x7fffu + ((u >> 16) & 1u)) >> 16; }
__device__ __forceinline__ unsigned pk2(float lo, float hi) { return f2bf(lo) | (f2bf(hi) << 16); }
__device__ __forceinline__ float bf2f(bf16_t b) { return __uint_as_float(((unsigned)b) << 16); }

struct Job { const float* src; int ldsrc, K, ncb, c0; bf16_t* dst; int lddst, dk0, kind, base; const float* scale; };
__device__ __forceinline__ void transpose_item(const Job& j, int item, LAS float* scr, int lane) {
    const int kb = item / j.ncb, nb = item % j.ncb, k0 = 64 * kb, cl = 32 * nb;
    const int drow0 = (j.kind == 0) ? j.base + cl : 256 * (cl >> 7) + (cl & 127) + j.base;
#pragma unroll 8
    for (int i = 0; i < 32; ++i) { const int kk = 2 * i + (lane >> 5); float v = j.src[(size_t)(k0 + kk) * j.ldsrc + j.c0 + cl + (lane & 31)]; if (j.scale) v *= j.scale[k0 + kk]; scr[kk * 33 + (lane & 31)] = v; }
    LDS_WAIT(); asm volatile("" ::: "memory");
    const int c = lane & 7;
#pragma unroll
    for (int jj = 0; jj < 4; ++jj) { const int n = (lane >> 3) + 8 * jj; const LAS float* s = scr + (8 * c) * 33 + n;
        u32x4 o; o.x = pk2(s[0 * 33], s[1 * 33]); o.y = pk2(s[2 * 33], s[3 * 33]); o.z = pk2(s[4 * 33], s[5 * 33]); o.w = pk2(s[6 * 33], s[7 * 33]);
        *(GAS u32x4*)(j.dst + (size_t)(drow0 + n) * j.lddst + j.dk0 + k0 + 8 * c) = o; }
    LDS_WAIT(); asm volatile("" ::: "memory");
}
__device__ __forceinline__ void run_job(Frame& F, const Job& j) {
    LAS float* scr = (LAS float*)(F.lds + F.wave * 16384);
    const int gw = F.vcu * NWAVES + F.wave, NGW = F.G * NWAVES, nit = (j.K / 64) * j.ncb;
    int first = gw - F.rot; if (first < 0) first += NGW;
    for (int it = first; it < nit; it += NGW) transpose_item(j, it, scr, F.lane);
    F.rot = (F.rot + nit) % NGW;
}
enum { I_X = 0, I_WIN, I_LB, I_GNW, I_CONVW, I_WPH, I_WPC, I_WOUT, I_NMIX, I_NFFN, I_DW1, I_DW3, I_DW2, I_RW, I_EW1, I_EW3, I_EW2, I_FN };

__device__ __forceinline__ void p_prologue(Frame& F) {
    F.rot = 0;
    bf16_t* W = (bf16_t*)(F.ws + WS_WNE);
    for (int L = 0; L < 2; ++L) {
        const float* win = F.in[I_WIN] + (size_t)L * D * INW; const float* nm = F.in[I_NMIX] + L * D;
        bf16_t* wa = W + WN_INA + (size_t)L * 4096 * 1024; bf16_t* wb = W + WN_INB + (size_t)L * 5120 * 1024;
        run_job(F, Job{win, INW, D, 128, 0, wa, 1024, 0, 0, 0, nm});
        run_job(F, Job{win, INW, D, 32, 4096, wb, 1024, 0, 1, 0, nm});
        run_job(F, Job{win, INW, D, 32, 6144, wb, 1024, 0, 1, 128, nm});
        run_job(F, Job{win, INW, D, 32, 5120, wb, 1024, 0, 0, 2048, nm});
        run_job(F, Job{win, INW, D, 32, 7168, wb, 1024, 0, 0, 3072, nm});
        run_job(F, Job{win, INW, D, 32, 8192, wb, 1024, 0, 0, 4096, nm});
        bf16_t* wp = W + WN_PROJ + (size_t)L * 1024 * 2048;
        run_job(F, Job{F.in[I_WPH] + (size_t)L * D * D, D, D, 32, 0, wp, 2048, 0, 0, 0, nullptr});
        run_job(F, Job{F.in[I_WPC] + (size_t)L * D * D, D, D, 32, 0, wp, 2048, 1024, 0, 0, nullptr});
        run_job(F, Job{F.in[I_WOUT] + (size_t)L * D * D, D, D, 32, 0, W + WN_OUT + (size_t)L * D * D, 1024, 0, 0, 0, nullptr});
    }
    run_job(F, Job{F.in[I_DW1], DFF, D, 88, 0, W + WN_D13, 1024, 0, 1, 0, F.in[I_NFFN]});
    run_job(F, Job{F.in[I_DW3], DFF, D, 88, 0, W + WN_D13, 1024, 0, 1, 128, F.in[I_NFFN]});
    run_job(F, Job{F.in[I_DW2], D, DFF, 32, 0, W + WN_D2, DFF, 0, 0, 0, nullptr});
    const int gw = F.vcu * NWAVES + F.wave, NGW = F.G * NWAVES;
    f32x4* ssq0 = (f32x4*)(F.ws + OFF_SSQ); bf16_t* XB = (bf16_t*)(F.ws + WS_XB);
    for (int m = gw; m < T; m += NGW) {
        const GAS f32x4* xr = (const GAS f32x4*)(F.in[I_X] + (size_t)m * D) + F.lane; GAS f32x4* xo = (GAS f32x4*)(F.X + (size_t)m * D) + F.lane;
        GAS unsigned long long* o8 = (GAS unsigned long long*)(XB + (size_t)m * D) + F.lane; float s = 0.f;
#pragma unroll
        for (int j = 0; j < 4; ++j) { const f32x4 v = xr[64 * j]; xo[64 * j] = v; s += (v.x * v.x + v.y * v.y) + (v.z * v.z + v.w * v.w);
            o8[64 * j] = (unsigned long long)pk2(v.x, v.y) | ((unsigned long long)pk2(v.z, v.w) << 32); }
        s = wave_sum(s); if (F.lane == 0) ssq0[m] = (f32x4){s, 0.f, 0.f, 0.f};
    }
    if (blockIdx.x == 0) { float* LBp = (float*)(F.ws + OFF_LB);
        for (int c = F.tid; c < 1024; c += NWAVES * 64) { const float l0 = F.in[I_LB][c], l1 = F.in[I_LB][1024 + c]; LBp[c] = 0.f; LBp[1024 + c] = 1.0f / (1.0f + __expf(l0 - l1)); } }
}
__device__ __forceinline__ void p_convert_experts(Frame& F) {
    F.rot = 0;
    bf16_t* W = (bf16_t*)(F.ws + WS_WE); const float* nf = F.in[I_NFFN] + D;
    for (int e = 0; e < NE; ++e) {
        bf16_t* w13 = W + WE_13 + (size_t)e * 5632 * 1024;
        run_job(F, Job{F.in[I_EW1] + (size_t)e * D * DFF, DFF, D, 88, 0, w13, 1024, 0, 1, 0, nf});
        run_job(F, Job{F.in[I_EW3] + (size_t)e * D * DFF, DFF, D, 88, 0, w13, 1024, 0, 1, 128, nf});
        run_job(F, Job{F.in[I_EW2] + (size_t)e * DFF * D, D, DFF, 32, 0, W + WE_2 + (size_t)e * 1024 * DFF, DFF, 0, 0, 0, nullptr});
    }
}

__device__ __forceinline__ void p_scan(Frame& F) {
    const bf16_t* P = (const bf16_t*)(F.ws + WS_P); bf16_t* O = (bf16_t*)(F.ws + WS_S);
    LAS f32x2* LQ = (LAS f32x2*)(F.lds);
    LAS float* IV = (LAS float*)(F.lds + 16384);
    LAS float* PART = (LAS float*)(F.lds + 16384 + 1024);
    const int tid = F.tid, k = tid >> 2, vq = tid & 3;
    for (int wi = F.vcu; wi < 256; wi += F.G) {
        const int bh = wi >> 3, vs = wi & 7, b = bh >> 3, h = bh & 7;
        const size_t rbase = (size_t)b * SEQ;
        const int lr = tid >> 5, lk = (tid & 31) * 4;
        float S0 = 0.f, S1 = 0.f, S2 = 0.f, S3 = 0.f;
        u32x2 rq, rf, rv = (u32x2){0u, 0u};
        { const bf16_t* rp = P + (rbase + lr) * 4096 + h * 128; rq = *(const u32x2*)(rp + lk); rf = *(const u32x2*)(rp + 1024 + lk);
          if (tid < 64) rv = *(const u32x2*)(P + (rbase + (tid >> 2)) * 4096 + 2048 + h * 128 + vs * 16 + (tid & 3) * 4); }
        for (int t0 = 0; t0 < SEQ; t0 += 16) {
            LQ[lr * 128 + lk + 0] = (f32x2){pg8::bf_lo(rf.x), pg8::bf_lo(rq.x)}; LQ[lr * 128 + lk + 1] = (f32x2){pg8::bf_hi(rf.x), pg8::bf_hi(rq.x)};
            LQ[lr * 128 + lk + 2] = (f32x2){pg8::bf_lo(rf.y), pg8::bf_lo(rq.y)}; LQ[lr * 128 + lk + 3] = (f32x2){pg8::bf_hi(rf.y), pg8::bf_hi(rq.y)};
            if (tid < 64) { LAS float* iv = IV + (tid >> 2) * 16 + (tid & 3) * 4; iv[0] = pg8::bf_lo(rv.x); iv[1] = pg8::bf_hi(rv.x); iv[2] = pg8::bf_lo(rv.y); iv[3] = pg8::bf_hi(rv.y); }
            __syncthreads();
            if (t0 + 16 < SEQ) { const bf16_t* rp = P + (rbase + t0 + 16 + lr) * 4096 + h * 128; rq = *(const u32x2*)(rp + lk); rf = *(const u32x2*)(rp + 1024 + lk);
                if (tid < 64) rv = *(const u32x2*)(P + (rbase + t0 + 16 + (tid >> 2)) * 4096 + 2048 + h * 128 + vs * 16 + (tid & 3) * 4); }
#pragma unroll 4
            for (int tt = 0; tt < 16; ++tt) {
                const f32x2 lq = LQ[tt * 128 + k]; const f32x4 iv = *(const LAS f32x4*)(IV + tt * 16 + vq * 4);
                const float f = __expf(lq.x), kk = 1.0f - f, q = lq.y;
                S0 = f * S0 + kk * iv.x; S1 = f * S1 + kk * iv.y; S2 = f * S2 + kk * iv.z; S3 = f * S3 + kk * iv.w;
                float p0 = q * S0, p1 = q * S1, p2 = q * S2, p3 = q * S3;
#pragma unroll
                for (int o = 4; o < 64; o <<= 1) { p0 += __shfl_xor(p0, o); p1 += __shfl_xor(p1, o); p2 += __shfl_xor(p2, o); p3 += __shfl_xor(p3, o); }
                if ((F.lane >> 2) == 0) *(LAS f32x4*)(PART + (tt * 8 + F.wave) * 16 + vq * 4) = (f32x4){p0, p1, p2, p3};
            }
            __syncthreads();
            if (tid < 256) { const int tt = tid >> 4, v = tid & 15; float s = 0.f;
#pragma unroll
                for (int w = 0; w < 8; ++w) s += PART[(tt * 8 + w) * 16 + v];
                O[(rbase + t0 + tt) * 1024 + h * 128 + vs * 16 + v] = (bf16_t)f2bf(s); }
        }
        __syncthreads();
    }
}
typedef float f32x16 __attribute__((ext_vector_type(16)));
typedef __bf16 bfx2_t __attribute__((ext_vector_type(2)));
#define MFMA32(a, b, c) __builtin_amdgcn_mfma_f32_32x32x16_bf16((a), (b), (c), 0, 0, 0)
__device__ __forceinline__ unsigned pkbf(float a, float b) { const f32x2 v = {a, b}; const bfx2_t r = __builtin_convertvector(v, bfx2_t); return __builtin_bit_cast(unsigned, r); }
__device__ __forceinline__ int img_off(int row, int ch) { return 256 * row + 16 * (ch ^ (((row & 3) << 2) | ((row >> 2) & 3))); }
__device__ __forceinline__ bf16x8 ldfrag(const LAS unsigned char* tile, int row, int ch) { return *(const LAS bf16x8*)(tile + img_off(row, ch)); }

__device__ __forceinline__ void p_r1(Frame& F) {
    const bf16_t* P = (const bf16_t*)(F.ws + WS_P); bf16_t* ST = (bf16_t*)(F.ws + WS_S); float* DEC = (float*)(F.ws + OFF_DEC);
    LAS unsigned char* KT = F.lds; LAS unsigned char* VT = F.lds + 32768; LAS f32x2* GT = (LAS f32x2*)(F.lds + RSCR_OFF);
    const int kp = F.lane, th = F.wave, r = F.lane & 31, hh = F.lane >> 5;
    for (int it = F.vcu; it < 2048; it += F.G) {
        const int bh = it >> 6, c = it & 63, b = bh >> 3, h = bh & 7;
        const bf16_t* base = P + ((size_t)b * SEQ + c * 128 + 16 * th) * 4096 + h * 128 + 2 * kp;
        unsigned lf2[16], iv2[16];
#pragma unroll
        for (int i = 0; i < 16; ++i) { lf2[i] = *(const unsigned*)(base + (size_t)i * 4096 + 1024); iv2[i] = *(const unsigned*)(base + (size_t)i * 4096 + 2048); }
        float c0[16], c1[16]; float a0 = 0.f, a1 = 0.f;
#pragma unroll
        for (int i = 0; i < 16; ++i) { a0 += pg8::bf_lo(lf2[i]); a1 += pg8::bf_hi(lf2[i]); c0[i] = a0; c1[i] = a1; }
        GT[th * 64 + kp] = (f32x2){a0, a1};
        __syncthreads();
        float o0 = 0.f, o1 = 0.f, t0 = 0.f, t1 = 0.f;
#pragma unroll
        for (int g = 0; g < 8; ++g) { const f32x2 v = GT[g * 64 + kp]; if (g < th) { o0 += v.x; o1 += v.y; } t0 += v.x; t1 += v.y; }
        unsigned k0p[8], k1p[8];
#pragma unroll
        for (int i = 0; i < 16; i += 2) {
            const float ka0 = (1.0f - __expf(pg8::bf_lo(lf2[i]))) * __expf(t0 - (o0 + c0[i])), kb0 = (1.0f - __expf(pg8::bf_lo(lf2[i + 1]))) * __expf(t0 - (o0 + c0[i + 1]));
            const float ka1 = (1.0f - __expf(pg8::bf_hi(lf2[i]))) * __expf(t1 - (o1 + c1[i])), kb1 = (1.0f - __expf(pg8::bf_hi(lf2[i + 1]))) * __expf(t1 - (o1 + c1[i + 1]));
            k0p[i >> 1] = pkbf(ka0, kb0); k1p[i >> 1] = pkbf(ka1, kb1); }
        *(LAS u32x4*)(KT + img_off(2 * kp, 2 * th)) = (u32x4){k0p[0], k0p[1], k0p[2], k0p[3]}; *(LAS u32x4*)(KT + img_off(2 * kp, 2 * th + 1)) = (u32x4){k0p[4], k0p[5], k0p[6], k0p[7]};
        *(LAS u32x4*)(KT + img_off(2 * kp + 1, 2 * th)) = (u32x4){k1p[0], k1p[1], k1p[2], k1p[3]}; *(LAS u32x4*)(KT + img_off(2 * kp + 1, 2 * th + 1)) = (u32x4){k1p[4], k1p[5], k1p[6], k1p[7]};
        unsigned v0p[8], v1p[8];
#pragma unroll
        for (int i = 0; i < 16; i += 2) { v0p[i >> 1] = (iv2[i] & 0xffffu) | (iv2[i + 1] << 16); v1p[i >> 1] = (iv2[i] >> 16) | (iv2[i + 1] & 0xffff0000u); }
        *(LAS u32x4*)(VT + img_off(2 * kp, 2 * th)) = (u32x4){v0p[0], v0p[1], v0p[2], v0p[3]}; *(LAS u32x4*)(VT + img_off(2 * kp, 2 * th + 1)) = (u32x4){v0p[4], v0p[5], v0p[6], v0p[7]};
        *(LAS u32x4*)(VT + img_off(2 * kp + 1, 2 * th)) = (u32x4){v1p[0], v1p[1], v1p[2], v1p[3]}; *(LAS u32x4*)(VT + img_off(2 * kp + 1, 2 * th + 1)) = (u32x4){v1p[4], v1p[5], v1p[6], v1p[7]};
        if (th == 0) *(f32x2*)(DEC + (size_t)it * 128 + 2 * kp) = (f32x2){__expf(t0), __expf(t1)};
        __syncthreads();
        const int ktile = th >> 1, vt0 = (th & 1) * 2;
        f32x16 acc0, acc1;
#pragma unroll
        for (int i = 0; i < 16; ++i) { acc0[i] = 0.f; acc1[i] = 0.f; }
#pragma unroll
        for (int ks = 0; ks < 8; ++ks) { const bf16x8 a = ldfrag(KT, 32 * ktile + r, 2 * ks + hh), b0 = ldfrag(VT, 32 * vt0 + r, 2 * ks + hh), b1 = ldfrag(VT, 32 * vt0 + 32 + r, 2 * ks + hh);
            acc0 = MFMA32(a, b0, acc0); acc1 = MFMA32(a, b1, acc1); }
        bf16_t* o = ST + (size_t)it * 16384 + 32 * ktile + 4 * hh;
#pragma unroll
        for (int g = 0; g < 4; ++g) {
            *(u32x2*)(o + (size_t)(32 * vt0 + r) * 128 + 8 * g) = (u32x2){pkbf(acc0[4 * g], acc0[4 * g + 1]), pkbf(acc0[4 * g + 2], acc0[4 * g + 3])};
            *(u32x2*)(o + (size_t)(32 * vt0 + 32 + r) * 128 + 8 * g) = (u32x2){pkbf(acc1[4 * g], acc1[4 * g + 1]), pkbf(acc1[4 * g + 2], acc1[4 * g + 3])}; }
        __syncthreads();
    }
}
__device__ __forceinline__ void p_r2(Frame& F) {
    bf16_t* ST = (bf16_t*)(F.ws + WS_S); const float* DEC = (const float*)(F.ws + OFF_DEC);
    for (int q = F.vcu * (NWAVES * 64) + F.tid; q < 32 * 4096; q += F.G * NWAVES * 64) {
        const int bh = q >> 12, e4 = q & 4095, v = e4 >> 5, k4 = (e4 & 31) * 4;
        bf16_t* p = ST + (size_t)bh * 64 * 16384 + v * 128 + k4; const float* d = DEC + (size_t)bh * 64 * 128 + k4;
        float S0 = 0.f, S1 = 0.f, S2 = 0.f, S3 = 0.f;
        for (int c0 = 0; c0 < 64; c0 += 8) {
            u32x2 ds[8]; f32x4 dd[8];
#pragma unroll
            for (int j = 0; j < 8; ++j) { ds[j] = *(const u32x2*)(p + (size_t)(c0 + j) * 16384); dd[j] = *(const f32x4*)(d + (size_t)(c0 + j) * 128); }
#pragma unroll
            for (int j = 0; j < 8; ++j) { *(u32x2*)(p + (size_t)(c0 + j) * 16384) = (u32x2){pkbf(S0, S1), pkbf(S2, S3)};
                S0 = dd[j].x * S0 + pg8::bf_lo(ds[j].x); S1 = dd[j].y * S1 + pg8::bf_hi(ds[j].x); S2 = dd[j].z * S2 + pg8::bf_lo(ds[j].y); S3 = dd[j].w * S3 + pg8::bf_hi(ds[j].y); }
        }
    }
}
__device__ __forceinline__ void p_r3(Frame& F, int L) {
    bf16_t* P = (bf16_t*)(F.ws + WS_P); const bf16_t* ST = (const bf16_t*)(F.ws + WS_S); const float* gw = F.in[I_GNW] + L * HV;
    LAS unsigned char* QD = F.lds; LAS unsigned char* KD = F.lds + 32768; LAS unsigned char* QB = F.lds + 65536; LAS unsigned char* KB = F.lds + 81920; LAS unsigned char* VT = F.lds + 98304;
    LAS f32x2* GT = (LAS f32x2*)(F.lds + RSCR_OFF); LAS float* EV = (LAS float*)(F.lds + RSCR_OFF + 4096); LAS float* NP = (LAS float*)(F.lds + RSCR_OFF + 5120);
    const int kp = F.lane, th = F.wave, r = F.lane & 31, hh = F.lane >> 5;
    const int tb = (th < 4) ? th : 7 - th, vh = th >> 2, subt = tb >> 1;
    for (int it = F.vcu; it < 2048; it += F.G) {
        const int bh = it >> 6, c = it & 63, b = bh >> 3, h = bh & 7;
        const size_t rowc = (size_t)b * SEQ + c * 128;
        {
            const bf16_t* base = P + (rowc + 16 * th) * 4096 + h * 128 + 2 * kp;
            unsigned lf2[16], q2[16], iv2[16];
#pragma unroll
            for (int i = 0; i < 16; ++i) { q2[i] = *(const unsigned*)(base + (size_t)i * 4096); lf2[i] = *(const unsigned*)(base + (size_t)i * 4096 + 1024); iv2[i] = *(const unsigned*)(base + (size_t)i * 4096 + 2048); }
            float c0[16], c1[16]; float a0 = 0.f, a1 = 0.f;
#pragma unroll
            for (int i = 0; i < 16; ++i) { a0 += pg8::bf_lo(lf2[i]); a1 += pg8::bf_hi(lf2[i]); c0[i] = a0; c1[i] = a1; }
            GT[th * 64 + kp] = (f32x2){a0, a1};
            __syncthreads();
            float o0 = 0.f, o1 = 0.f, r00 = 0.f, r01 = 0.f, m0 = 0.f, m1 = 0.f, r10 = 0.f, r11 = 0.f;
#pragma unroll
            for (int g = 0; g < 6; ++g) { const f32x2 v = GT[g * 64 + kp]; if (g < th) { o0 += v.x; o1 += v.y; } if (g < 2) { r00 += v.x; r01 += v.y; } if (g < 4) { m0 += v.x; m1 += v.y; } r10 += v.x; r11 += v.y; }
            { const f32x2 v = GT[6 * 64 + kp]; if (6 < th) { o0 += v.x; o1 += v.y; } }
            const bool sub = th >= 4; const float rd0 = sub ? r10 : r00, rd1 = sub ? r11 : r01;
            const int chq = kp >> 2, inq = (kp & 3) * 4;
#pragma unroll
            for (int i = 0; i < 16; ++i) {
                const int t = 16 * th + i;
                const float cu0 = o0 + c0[i], cu1 = o1 + c1[i];
                const float kk0 = 1.0f - __expf(pg8::bf_lo(lf2[i])), kk1 = 1.0f - __expf(pg8::bf_hi(lf2[i])), q0 = pg8::bf_lo(q2[i]), q1 = pg8::bf_hi(q2[i]);
                const unsigned qd = pkbf(q0 * __expf(fminf(cu0 - rd0, 80.f)), q1 * __expf(fminf(cu1 - rd1, 80.f)));
                const unsigned kd = pkbf(kk0 * __expf(fminf(rd0 - cu0, 80.f)), kk1 * __expf(fminf(rd1 - cu1, 80.f)));
                *(LAS unsigned*)(QD + img_off(t, chq) + inq) = qd; *(LAS unsigned*)(KD + img_off(t, chq) + inq) = kd;
                if (sub) *(LAS unsigned*)(QB + img_off(t - 64, chq) + inq) = pkbf(q0 * __expf(cu0 - m0), q1 * __expf(cu1 - m1));
                else     *(LAS unsigned*)(KB + img_off(t, chq) + inq) = pkbf(kk0 * __expf(m0 - cu0), kk1 * __expf(m1 - cu1));
            }
            unsigned v0p[8], v1p[8];
#pragma unroll
            for (int a = 0; a < 2; ++a)
#pragma unroll
                for (int e = 0; e < 4; ++e) { const int i0 = (e < 2 ? 0 : 8) + 4 * a + 2 * (e & 1);
                    v0p[4 * a + e] = (iv2[i0] & 0xffffu) | (iv2[i0 + 1] << 16); v1p[4 * a + e] = (iv2[i0] >> 16) | (iv2[i0 + 1] & 0xffff0000u); }
            *(LAS u32x4*)(VT + img_off(2 * kp, 2 * th)) = (u32x4){v0p[0], v0p[1], v0p[2], v0p[3]}; *(LAS u32x4*)(VT + img_off(2 * kp, 2 * th + 1)) = (u32x4){v0p[4], v0p[5], v0p[6], v0p[7]};
            *(LAS u32x4*)(VT + img_off(2 * kp + 1, 2 * th)) = (u32x4){v1p[0], v1p[1], v1p[2], v1p[3]}; *(LAS u32x4*)(VT + img_off(2 * kp + 1, 2 * th + 1)) = (u32x4){v1p[4], v1p[5], v1p[6], v1p[7]};
            if (th == 0) { *(LAS f32x2*)(EV + 2 * kp) = (f32x2){__expf(r00), __expf(r01)}; *(LAS f32x2*)(EV + 128 + 2 * kp) = (f32x2){__expf(m0), __expf(m1)}; }
        }
        __syncthreads();
        f32x16 oa, ob;
#pragma unroll
        for (int i = 0; i < 16; ++i) { oa[i] = 0.f; ob[i] = 0.f; }
        for (int j = 0; j <= tb; ++j) {
            const bool same = (j >> 1) == subt;
            const LAS unsigned char* Kt = same ? KD : KB; const LAS unsigned char* Qt = same ? QD : QB; const int qrow = same ? 32 * tb : 32 * tb - 64;
            f32x16 X;
#pragma unroll
            for (int i = 0; i < 16; ++i) X[i] = 0.f;
#pragma unroll
            for (int ks = 0; ks < 8; ++ks) X = MFMA32(ldfrag(Kt, 32 * j + r, 2 * ks + hh), ldfrag(Qt, qrow + r, 2 * ks + hh), X);
            if (j == tb) {
#pragma unroll
                for (int i = 0; i < 16; ++i) { const int sl = (i & 3) + 8 * (i >> 2) + 4 * hh; X[i] = (sl > r) ? 0.f : X[i]; }
            }
#pragma unroll
            for (int sp = 0; sp < 2; ++sp) {
                const u32x4 xp = (u32x4){pkbf(X[8 * sp], X[8 * sp + 1]), pkbf(X[8 * sp + 2], X[8 * sp + 3]), pkbf(X[8 * sp + 4], X[8 * sp + 5]), pkbf(X[8 * sp + 6], X[8 * sp + 7])};
                const bf16x8 xf = __builtin_bit_cast(bf16x8, xp);
                oa = MFMA32(ldfrag(VT, vh * 64 + r, 4 * j + 2 * sp + hh), xf, oa); ob = MFMA32(ldfrag(VT, vh * 64 + 32 + r, 4 * j + 2 * sp + hh), xf, ob);
            }
        }
        {
            const LAS unsigned char* Qt = subt ? QB : QD; const int qrow = subt ? 32 * tb - 64 : 32 * tb; const LAS float* ev = EV + subt * 128;
            const bf16_t* sp0 = ST + (size_t)it * 16384 + (size_t)(vh * 64 + r) * 128 + 8 * hh;
#pragma unroll
            for (int ks = 0; ks < 8; ++ks) {
                const bf16x8 bq = ldfrag(Qt, qrow + r, 2 * ks + hh);
                const f32x4 e0 = *(const LAS f32x4*)(ev + 16 * ks + 8 * hh), e1 = *(const LAS f32x4*)(ev + 16 * ks + 8 * hh + 4);
                const u32x4 ra = *(const u32x4*)(sp0 + 16 * ks), rb = *(const u32x4*)(sp0 + 32 * 128 + 16 * ks);
                const u32x4 sa = (u32x4){pkbf(pg8::bf_lo(ra.x) * e0.x, pg8::bf_hi(ra.x) * e0.y), pkbf(pg8::bf_lo(ra.y) * e0.z, pg8::bf_hi(ra.y) * e0.w), pkbf(pg8::bf_lo(ra.z) * e1.x, pg8::bf_hi(ra.z) * e1.y), pkbf(pg8::bf_lo(ra.w) * e1.z, pg8::bf_hi(ra.w) * e1.w)};
                const u32x4 sb = (u32x4){pkbf(pg8::bf_lo(rb.x) * e0.x, pg8::bf_hi(rb.x) * e0.y), pkbf(pg8::bf_lo(rb.y) * e0.z, pg8::bf_hi(rb.y) * e0.w), pkbf(pg8::bf_lo(rb.z) * e1.x, pg8::bf_hi(rb.z) * e1.y), pkbf(pg8::bf_lo(rb.w) * e1.z, pg8::bf_hi(rb.w) * e1.w)};
                oa = MFMA32(__builtin_bit_cast(bf16x8, sa), bq, oa); ob = MFMA32(__builtin_bit_cast(bf16x8, sb), bq, ob);
            }
        }
        float ss = 0.f;
#pragma unroll
        for (int i = 0; i < 16; ++i) ss += oa[i] * oa[i] + ob[i] * ob[i];
        ss += __shfl_xor(ss, 32);
        if (hh == 0) NP[th * 32 + r] = ss;
        __syncthreads();
        const float rstd = __builtin_amdgcn_rsqf((ss + NP[(7 - th) * 32 + r]) * (1.0f / 128.0f) + EPS);
        bf16_t* prow = P + (rowc + 32 * tb + r) * 4096 + h * 128 + vh * 64 + 4 * hh;
        const float* gwp = gw + vh * 64 + 4 * hh;
#pragma unroll
        for (int g = 0; g < 4; ++g) {
            const u32x2 sga = *(const u32x2*)(prow + 3072 + 8 * g), sgb = *(const u32x2*)(prow + 3072 + 32 + 8 * g);
            const f32x4 ga = *(const f32x4*)(gwp + 8 * g), gb = *(const f32x4*)(gwp + 32 + 8 * g);
            *(u32x2*)(prow + 8 * g) = (u32x2){pkbf(oa[4 * g] * rstd * ga.x * pg8::bf_lo(sga.x), oa[4 * g + 1] * rstd * ga.y * pg8::bf_hi(sga.x)), pkbf(oa[4 * g + 2] * rstd * ga.z * pg8::bf_lo(sga.y), oa[4 * g + 3] * rstd * ga.w * pg8::bf_hi(sga.y))};
            *(u32x2*)(prow + 32 + 8 * g) = (u32x2){pkbf(ob[4 * g] * rstd * gb.x * pg8::bf_lo(sgb.x), ob[4 * g + 1] * rstd * gb.y * pg8::bf_hi(sgb.x)), pkbf(ob[4 * g + 2] * rstd * gb.z * pg8::bf_lo(sgb.y), ob[4 * g + 3] * rstd * gb.w * pg8::bf_hi(sgb.y))};
        }
        __syncthreads();
    }
}
__device__ __forceinline__ void p_onorm(Frame& F, int L) {
    bf16_t* P = (bf16_t*)(F.ws + WS_P); const bf16_t* O = (const bf16_t*)(F.ws + WS_S); const float* gw = F.in[I_GNW] + L * HV;
    const int gw_ = F.vcu * NWAVES + F.wave, NGW = F.G * NWAVES, c0 = (F.lane & 7) * 16;
    float g[16];
#pragma unroll
    for (int j = 0; j < 16; ++j) g[j] = gw[c0 + j];
    for (int m = gw_; m < T; m += NGW) {
        const u32x4 o0 = *(const u32x4*)(O + (size_t)m * 1024 + F.lane * 16), o1 = *(const u32x4*)(O + (size_t)m * 1024 + F.lane * 16 + 8);
        const u32x4 s0 = *(const u32x4*)(P + (size_t)m * 4096 + 3072 + F.lane * 16), s1 = *(const u32x4*)(P + (size_t)m * 4096 + 3072 + F.lane * 16 + 8);
        float v[16], sg[16];
#pragma unroll
        for (int q = 0; q < 4; ++q) { v[2 * q] = pg8::bf_lo(o0[q]); v[2 * q + 1] = pg8::bf_hi(o0[q]); v[8 + 2 * q] = pg8::bf_lo(o1[q]); v[8 + 2 * q + 1] = pg8::bf_hi(o1[q]);
            sg[2 * q] = pg8::bf_lo(s0[q]); sg[2 * q + 1] = pg8::bf_hi(s0[q]); sg[8 + 2 * q] = pg8::bf_lo(s1[q]); sg[8 + 2 * q + 1] = pg8::bf_hi(s1[q]); }
        float s = 0.f;
#pragma unroll
        for (int j = 0; j < 16; ++j) s += v[j] * v[j];
        s += __shfl_xor(s, 1); s += __shfl_xor(s, 2); s += __shfl_xor(s, 4);
        const float r = __builtin_amdgcn_rsqf(s * (1.0f / 128.0f) + EPS);
        u32x4 w0, w1;
#pragma unroll
        for (int q = 0; q < 4; ++q) { w0[q] = pk2(v[2 * q] * r * g[2 * q] * sg[2 * q], v[2 * q + 1] * r * g[2 * q + 1] * sg[2 * q + 1]);
            w1[q] = pk2(v[8 + 2 * q] * r * g[8 + 2 * q] * sg[8 + 2 * q], v[8 + 2 * q + 1] * r * g[8 + 2 * q + 1] * sg[8 + 2 * q + 1]); }
        *(u32x4*)(P + (size_t)m * 4096 + F.lane * 16) = w0; *(u32x4*)(P + (size_t)m * 4096 + F.lane * 16 + 8) = w1;
    }
}
__device__ __forceinline__ void p_conv(Frame& F, int L) {
    bf16_t* P = (bf16_t*)(F.ws + WS_P); const float* cw = F.in[I_CONVW] + (size_t)L * 3 * D;
    const int cb = (F.tid & 127) * 8, rsub = F.tid >> 7;
    float w0[8], w1[8], w2[8];
#pragma unroll
    for (int j = 0; j < 8; ++j) { w0[j] = cw[cb + j]; w1[j] = cw[D + cb + j]; w2[j] = cw[2 * D + cb + j]; }
    const int rows_per = T / F.G;
    for (int rr = rsub; rr < rows_per; rr += 4) {
        const int m = F.vcu * rows_per + rr, t = m & (SEQ - 1);
        const u32x4 z = (u32x4){0u, 0u, 0u, 0u};
        const u32x4 v2 = *(const u32x4*)(P + (size_t)m * 4096 + 1024 + cb);
        const u32x4 v1 = (t >= 1) ? *(const u32x4*)(P + (size_t)(m - 1) * 4096 + 1024 + cb) : z;
        const u32x4 v0 = (t >= 2) ? *(const u32x4*)(P + (size_t)(m - 2) * 4096 + 1024 + cb) : z;
        const u32x4 c = *(const u32x4*)(P + (size_t)m * 4096 + 2048 + cb);
        u32x4 o;
#pragma unroll
        for (int q = 0; q < 4; ++q) {
            const float a = pg8::bf_lo(c[q]) * (w0[2 * q] * pg8::bf_lo(v0[q]) + w1[2 * q] * pg8::bf_lo(v1[q]) + w2[2 * q] * pg8::bf_lo(v2[q]));
            const float b = pg8::bf_hi(c[q]) * (w0[2 * q + 1] * pg8::bf_hi(v0[q]) + w1[2 * q + 1] * pg8::bf_hi(v1[q]) + w2[2 * q + 1] * pg8::bf_hi(v2[q]));
            o[q] = pk2(a, b); }
        *(u32x4*)(P + (size_t)m * 4096 + 2048 + cb) = o;
    }
}
__device__ __forceinline__ void p_route1(Frame& F) {
    LAS float* RW = (LAS float*)F.lds;
    LAS unsigned* CNT = (LAS unsigned*)(F.lds + 32768);
    const float* nf = F.in[I_NFFN] + D; const float* rw = F.in[I_RW];
    for (int i = F.tid; i < 8192; i += NWAVES * 64) RW[i] = rw[i] * nf[i >> 3];
    if (F.tid < 16) CNT[F.tid] = 0u;
    __syncthreads();
    const float* ssq = (const float*)(F.ws + OFF_SSQ) + (size_t)3 * T * 4;
    f32x4* route = (f32x4*)(F.ws + OFF_ROUTE);
    const int per = T / F.G;
    for (int i = F.wave; i < per; i += NWAVES) {
        const int m = F.vcu * per + i;
        float lg[8];
#pragma unroll
        for (int e = 0; e < 8; ++e) lg[e] = 0.f;
#pragma unroll
        for (int j = 0; j < 4; ++j) { const f32x4 v = *((const GAS f32x4*)(F.X + (size_t)m * D) + F.lane + 64 * j); const int k0 = (F.lane + 64 * j) * 4;
#pragma unroll
            for (int q = 0; q < 4; ++q) { const f32x4 r0 = *(const LAS f32x4*)(RW + (k0 + q) * 8), r1 = *(const LAS f32x4*)(RW + (k0 + q) * 8 + 4);
                lg[0] += v[q] * r0.x; lg[1] += v[q] * r0.y; lg[2] += v[q] * r0.z; lg[3] += v[q] * r0.w; lg[4] += v[q] * r1.x; lg[5] += v[q] * r1.y; lg[6] += v[q] * r1.z; lg[7] += v[q] * r1.w; } }
#pragma unroll
        for (int e = 0; e < 8; ++e) lg[e] = wave_sum(lg[e]);
        const float rstd = pg8::rstd_of(ssq, m);
        int e1 = 0; float v1 = lg[0];
#pragma unroll
        for (int e = 1; e < 8; ++e) if (lg[e] > v1) { v1 = lg[e]; e1 = e; }
        int e2 = -1; float v2 = -3.0e38f;
#pragma unroll
        for (int e = 0; e < 8; ++e) if (e != e1 && lg[e] > v2) { v2 = lg[e]; e2 = e; }
        const float g1 = 1.0f / (1.0f + __expf((v2 - v1) * rstd)), g2 = 1.0f - g1;
        if (F.lane == 0) { route[m] = (f32x4){__int_as_float(e1), __int_as_float(e2), g1, g2}; __hip_atomic_fetch_add(CNT + e1, 1u, __ATOMIC_RELAXED, __HIP_MEMORY_SCOPE_WORKGROUP); __hip_atomic_fetch_add(CNT + 8 + e2, 1u, __ATOMIC_RELAXED, __HIP_MEMORY_SCOPE_WORKGROUP); }
    }
    __syncthreads();
    if (F.tid < 16) __hip_atomic_store((unsigned*)(F.ws + OFF_BLKCNT) + F.vcu * 16 + F.tid, CNT[F.tid], RLX_AGENT);
}
__device__ __forceinline__ void p_route2(Frame& F) {
    LAS unsigned* TOT = (LAS unsigned*)F.lds;
    LAS unsigned* PRE = TOT + 16;
    LAS unsigned* BASE = PRE + 16;
    LAS unsigned* PT = BASE + 16;
    LAS f32x4* RT = (LAS f32x4*)(F.lds + 8192);
    LAS float* RS = (LAS float*)(F.lds + 8192 + 4096);
    const unsigned* bc = (const unsigned*)(F.ws + OFF_BLKCNT);
    const f32x4* route = (const f32x4*)(F.ws + OFF_ROUTE); const float* ssq = (const float*)(F.ws + OFF_SSQ) + (size_t)3 * T * 4;
    const int per = T / F.G;
    { const int ent = F.tid & 15, ch = F.tid >> 4; unsigned tot = 0, pre = 0;
      for (int b = ch * 8; b < ch * 8 + 8 && b < F.G; ++b) { const unsigned c = __hip_atomic_load(bc + b * 16 + ent, RLX_AGENT); tot += c; if (b < F.vcu) pre += c; }
      PT[ch * 16 + ent] = tot; PT[512 + ch * 16 + ent] = pre; }
    for (int i = F.tid; i < per; i += NWAVES * 64) { const int m = F.vcu * per + i; RT[i] = route[m]; RS[i] = pg8::rstd_of(ssq, m); }
    __syncthreads();
    if (F.tid < 16) { unsigned tot = 0, pre = 0; for (int ch = 0; ch < 32; ++ch) { tot += PT[ch * 16 + F.tid]; pre += PT[512 + ch * 16 + F.tid]; } TOT[F.tid] = tot; PRE[F.tid] = pre; }
    __syncthreads();
    if (F.tid < 2) { unsigned base = 0; for (int e = 0; e < 8; ++e) { BASE[F.tid * 8 + e] = base; base += (TOT[F.tid * 8 + e] + 255u) & ~255u; } }
    __syncthreads();
    int* tok = (int*)(F.ws + OFF_TOK); float* gate = (float*)(F.ws + OFF_GATE); float* rss = (float*)(F.ws + OFF_RSS);
    if (F.tid < 16) { const int r = F.tid >> 3, e = F.tid & 7; unsigned pos = BASE[F.tid] + PRE[F.tid];
        for (int i = 0; i < per; ++i) { const f32x4 rt = RT[i]; const int ee = __float_as_int(r == 0 ? rt.x : rt.y);
            if (ee == e) { tok[r * NS + pos] = F.vcu * per + i; gate[r * NS + pos] = (r == 0) ? rt.z : rt.w; rss[r * NS + pos] = RS[i]; ++pos; } } }
    if (blockIdx.x == 0) {
        unsigned* meta = (unsigned*)(F.ws + OFF_META);
        if (F.tid < 16) { const int r = F.tid >> 3; const unsigned n = TOT[F.tid], b0 = BASE[F.tid], pe = (n + 255u) & ~255u;
            for (unsigned s = b0 + n; s < b0 + pe; ++s) { tok[r * NS + s] = -1; gate[r * NS + s] = 0.f; rss[r * NS + s] = 0.f; }
            for (unsigned tl = b0 / 256; tl < (b0 + pe) / 256; ++tl) __hip_atomic_store(meta + 16 + r * 256 + tl, (unsigned)(F.tid & 7), RLX_AGENT); }
        if (F.tid < 2) { unsigned nt = 0; for (int e = 0; e < 8; ++e) nt += (TOT[F.tid * 8 + e] + 255u) >> 8; __hip_atomic_store(meta + F.tid, nt, RLX_AGENT); }
    }
}
__device__ __forceinline__ void p_gather(Frame& F, int r) {
    const int* tok = (const int*)(F.ws + OFF_TOK) + r * NS; const bf16_t* XB = (const bf16_t*)(F.ws + WS_XB); bf16_t* AG = (bf16_t*)(F.ws + WS_AG);
    const unsigned nt = __hip_atomic_load((const unsigned*)(F.ws + OFF_META) + r, RLX_AGENT); const int nrows = (int)nt * 256;
    const int gw = F.vcu * NWAVES + F.wave, NGW = F.G * NWAVES;
    for (int s = gw; s < nrows; s += NGW) { const int tk = __hip_atomic_load(tok + s, RLX_AGENT);
        u32x4 a = (u32x4){0u, 0u, 0u, 0u}, b = a;
        if (tk >= 0) { a = *(const u32x4*)(XB + (size_t)tk * 1024 + F.lane * 8); b = *(const u32x4*)(XB + (size_t)tk * 1024 + 512 + F.lane * 8); }
        *(u32x4*)(AG + (size_t)s * 1024 + F.lane * 8) = a; *(u32x4*)(AG + (size_t)s * 1024 + 512 + F.lane * 8) = b; }
}
__device__ __forceinline__ void p_final(Frame& F) {
    const int gw = F.vcu * NWAVES + F.wave, NGW = F.G * NWAVES; const float* fn = F.in[I_FN];
    f32x4 w[4];
#pragma unroll
    for (int j = 0; j < 4; ++j) w[j] = *((const f32x4*)fn + F.lane + 64 * j);
    for (int m = gw; m < T; m += NGW) { GAS f32x4* xr = (GAS f32x4*)(F.X + (size_t)m * D) + F.lane; f32x4 v[4]; float s = 0.f;
#pragma unroll
        for (int j = 0; j < 4; ++j) { v[j] = xr[64 * j]; s += (v[j].x * v[j].x + v[j].y * v[j].y) + (v[j].z * v[j].z + v[j].w * v[j].w); }
        const float r = __builtin_amdgcn_rsqf(wave_sum(s) * (1.0f / 1024.0f) + EPS);
#pragma unroll
        for (int j = 0; j < 4; ++j) xr[64 * j] = v[j] * r * w[j]; }
}

struct Args { const float* in[18]; float* out; unsigned char* ws; int ph_lo, ph_hi; };
__global__ void __launch_bounds__(NWAVES * 64, 2) mk_fwd(Args args) {
    extern __shared__ __attribute__((aligned(16))) unsigned char lds[];
    Frame F;
    F.lds = (LAS unsigned char*)lds; F.MISC = (volatile LAS unsigned*)(F.lds + MISC_OFF);
    F.tid = threadIdx.x; F.lane = F.tid & 63; F.wave = __builtin_amdgcn_readfirstlane(F.tid >> 6);
    F.G = gridDim.x; { const int bx = blockIdx.x; F.vcu = (F.G % 8 == 0) ? (bx % 8) * (F.G / 8) + bx / 8 : bx; }
    F.ws = args.ws; F.X = args.out;
    F.in = args.in;
    unsigned* ctl = (unsigned*)(F.ws + WS_CTL);
    for (int u = F.tid; u < (LDS_BYTES - LDSCTL_OFF) / 4; u += NWAVES * 64) ((LAS unsigned*)(F.lds + LDSCTL_OFF))[u] = 0u;
    __syncthreads();
    XcdBarrier bar; bar.bar = ctl + CW_BAR; bar.x = 0; bar.st = nullptr;
    if (!MK_PER_PHASE) bar = xcd_barrier_post(ctl + CW_BAR, F.MISC + 8);
    const int lo = args.ph_lo, hi = args.ph_hi; int ph = 0;
#ifndef PH_MASK
#define PH_MASK 0xFFFFFFFFu
#endif
#define PH_ON(k) (((PH_MASK) >> (k)) & 1u)
#define PHASE_BEGIN(k) if (PH_ON(k) && ph >= lo && ph < hi) { asm volatile("" : "+v"(F.tid), "+v"(F.lane), "+s"(F.vcu), "+s"(F.ws), "+s"(F.X)); \
    bf16_t* const P = (bf16_t*)(F.ws + WS_P); bf16_t* const SB = (bf16_t*)(F.ws + WS_S); bf16_t* const XB = (bf16_t*)(F.ws + WS_XB); \
    bf16_t* const WNE = (bf16_t*)(F.ws + WS_WNE); float* const SSQ = (float*)(F.ws + OFF_SSQ); const float* const LBp = (const float*)(F.ws + OFF_LB); \
    (void)P; (void)SB; (void)XB; (void)WNE; (void)SSQ; (void)LBp;
#define PHASE_END(last) if (!MK_PER_PHASE && !(last)) xcd_barrier(bar); } ++ph;

    PHASE_BEGIN(0) p_prologue(F); PHASE_END(false)

#pragma nounroll
    for (int L = 0; L < 2; ++L) {
        PHASE_BEGIN(1)
            pg8::Gemm g{XB, WNE + WN_INA + (size_t)L * 4096 * 1024, 1024, 1024, 0, 0}; pg8::StaticOrder S; S.init(T / 256, 16, F.G, (int)blockIdx.x);
            pg8::EpiG1a E{P, SSQ + (size_t)(2 * L) * T * 4, LBp + L * 1024}; pg8::gemm_phase(F.lds, g, S, E);
        PHASE_END(false)
#if USE_NAIVE_SCAN
        PHASE_BEGIN(2) p_scan(F); PHASE_END(false)
        PHASE_BEGIN(3) p_onorm(F, L); PHASE_END(false)
#else
        PHASE_BEGIN(2) p_r1(F); PHASE_END(false)
        PHASE_BEGIN(16) p_r2(F); PHASE_END(false)
        PHASE_BEGIN(3) p_r3(F, L); PHASE_END(false)
#endif
        PHASE_BEGIN(4)
            pg8::Gemm g{XB, WNE + WN_INB + (size_t)L * 5120 * 1024, 1024, 1024, 0, 0}; pg8::StaticOrder S; S.init(T / 256, 20, F.G, (int)blockIdx.x);
            pg8::EpiG1b E{P, SB, SSQ + (size_t)(2 * L) * T * 4}; pg8::gemm_phase(F.lds, g, S, E);
        PHASE_END(false)
        PHASE_BEGIN(5) p_conv(F, L); PHASE_END(false)
        PHASE_BEGIN(6)
            pg8::Gemm g{P, WNE + WN_PROJ + (size_t)L * 1024 * 2048, 4096, 2048, 2048, 0}; pg8::StaticOrder S; S.init(T / 256, 4, F.G, (int)blockIdx.x);
            pg8::EpiG2 E{P, SB}; pg8::gemm_phase(F.lds, g, S, E);
        PHASE_END(false)
        PHASE_BEGIN(7)
            pg8::Gemm g{P + 1024, WNE + WN_OUT + (size_t)L * 1024 * 1024, 4096, 1024, 0, 0}; pg8::StaticOrder S; S.init(T / 256, 4, F.G, (int)blockIdx.x);
            pg8::EpiRes E{F.X, XB, SSQ + (size_t)(2 * L + 1) * T * 4, (LAS float*)(F.lds + RED_OFF)}; pg8::gemm_phase(F.lds, g, S, E);
        PHASE_END(false)
        if (L == 0) {
            PHASE_BEGIN(8)
                pg8::Gemm g{XB, WNE + WN_D13, 1024, 1024, 0, 0}; pg8::StaticOrder S; S.init(T / 256, 22, F.G, (int)blockIdx.x);
                pg8::EpiSwiglu<false> E{P, SSQ + (size_t)T * 4}; pg8::gemm_phase(F.lds, g, S, E);
            PHASE_END(false)
            PHASE_BEGIN(9)
                pg8::Gemm g{P, WNE + WN_D2, DFF, DFF, 0, 0}; pg8::StaticOrder S; S.init(T / 256, 4, F.G, (int)blockIdx.x);
                pg8::EpiRes E{F.X, XB, SSQ + (size_t)2 * T * 4, (LAS float*)(F.lds + RED_OFF)}; pg8::gemm_phase(F.lds, g, S, E);
            PHASE_END(false)
        } else {
            PHASE_BEGIN(10) p_convert_experts(F); __syncthreads(); p_route1(F); PHASE_END(false)
            PHASE_BEGIN(11) p_route2(F); PHASE_END(false)
            PHASE_BEGIN(12) p_gather(F, 0); PHASE_END(false)
#pragma nounroll
            for (int r = 0; r < 2; ++r) {
                PHASE_BEGIN(13)
                    const unsigned* meta = (const unsigned*)(F.ws + OFF_META);
                    const int nt = (int)__builtin_amdgcn_readfirstlane(__hip_atomic_load(meta + r, RLX_AGENT));
                    pg8::Gemm g{(const bf16_t*)(F.ws + WS_AG), (const bf16_t*)(F.ws + WS_WE) + WE_13, 1024, 1024, 0, (size_t)5632 * 1024}; pg8::MoeOrder S; S.so.init(nt, 22, F.G, (int)blockIdx.x); S.tile_e = meta + 16 + r * 256;
                    pg8::EpiSwiglu<true> E{(bf16_t*)(F.ws + WS_H), (const float*)(F.ws + OFF_RSS) + r * NS}; pg8::gemm_phase(F.lds, g, S, E);
                PHASE_END(false)
                PHASE_BEGIN(14)
                    if (r == 0) p_gather(F, 1);
                    const unsigned* meta = (const unsigned*)(F.ws + OFF_META);
                    const int nt = (int)__builtin_amdgcn_readfirstlane(__hip_atomic_load(meta + r, RLX_AGENT));
                    pg8::Gemm g{(const bf16_t*)(F.ws + WS_H), (const bf16_t*)(F.ws + WS_WE) + WE_2, DFF, DFF, 0, (size_t)1024 * DFF}; pg8::MoeOrder S; S.so.init(nt, 4, F.G, (int)blockIdx.x); S.tile_e = meta + 16 + r * 256;
                    pg8::EpiDown E{F.X, (const int*)(F.ws + OFF_TOK) + r * NS, (const float*)(F.ws + OFF_GATE) + r * NS}; pg8::gemm_phase(F.lds, g, S, E);
                PHASE_END(false)
            }
        }
    }
    PHASE_BEGIN(15) p_final(F); PHASE_END(true)
}
constexpr int N_PHASES = 1 + 7 + 2 + 7 + 3 + 4 + 1 + (USE_NAIVE_SCAN ? 0 : 2);

extern "C" void kernel_launch(void* const* d_in, const int* in_sizes, int n_in, void* d_out, int out_size, void* d_ws, size_t ws_size, hipStream_t stream) {
    static int grid = 0;
    if (grid == 0) {
        if (n_in != 18 || in_sizes[0] != T * D || out_size != T * D || ws_size < WS_END) { fprintf(stderr, "kernel_launch: unexpected shapes / workspace (n_in %d, ws %zu, need %zu); nothing launched\n", n_in, ws_size, (size_t)WS_END); grid = -1; return; }
        int dev = 0, cus = 0, per_cu = 0;
        if (hipGetDevice(&dev) != hipSuccess || hipDeviceGetAttribute(&cus, hipDeviceAttributeMultiprocessorCount, dev) != hipSuccess) { grid = -1; return; }
        if (hipFuncSetAttribute((const void*)mk_fwd, hipFuncAttributeMaxDynamicSharedMemorySize, LDS_BYTES) != hipSuccess) { fprintf(stderr, "kernel_launch: hipFuncSetAttribute failed\n"); grid = -1; return; }
        if (hipOccupancyMaxActiveBlocksPerMultiprocessor(&per_cu, (const void*)mk_fwd, NWAVES * 64, LDS_BYTES) != hipSuccess || per_cu < 1) { fprintf(stderr, "kernel_launch: occupancy query says %d\n", per_cu); }
        (void)hipGetLastError();
        grid = cus;
    }
    if (grid < 0) return;
    if (hipMemsetAsync((char*)d_ws + WS_CTL, 0, ZERO_BYTES, stream) != hipSuccess) return;
    Args a{};
    for (int i = 0; i < 18; ++i) a.in[i] = (const float*)d_in[i];
    a.out = (float*)d_out; a.ws = (unsigned char*)d_ws;
#if MK_PER_PHASE
    for (int p = 0; p < N_PHASES; ++p) { a.ph_lo = p; a.ph_hi = p + 1; hipLaunchKernelGGL(mk_fwd, dim3(grid), dim3(NWAVES * 64), LDS_BYTES, stream, a); }
#else
    a.ph_lo = 0; a.ph_hi = N_PHASES; hipLaunchKernelGGL(mk_fwd, dim3(grid), dim3(NWAVES * 64), LDS_BYTES, stream, a);
#endif
}
```

```cpp
#include <hip/hip_runtime.h>
#include <cstdio>
#include <cstdint>

#ifndef PROBE_A
#define PROBE_A -1
#define PROBE_B -1
#define PROBE_DIV 2000.0f
#define PROBE_Q 1600
#endif
#ifndef USE_NAIVE_SCAN
#define USE_NAIVE_SCAN 0
#endif
#ifndef MK_PER_PHASE
#define MK_PER_PHASE 0
#endif

#define LAS __attribute__((address_space(3)))
#define GAS __attribute__((address_space(1)))
typedef unsigned short bf16_t;
typedef short bf16x8 __attribute__((ext_vector_type(8)));
typedef float f32x4 __attribute__((ext_vector_type(4)));
typedef float f32x2 __attribute__((ext_vector_type(2)));
typedef unsigned u32x4 __attribute__((ext_vector_type(4)));
typedef unsigned u32x2 __attribute__((ext_vector_type(2)));
#define RLX_AGENT __ATOMIC_RELAXED, __HIP_MEMORY_SCOPE_AGENT

constexpr int D = 1024, BATCH = 4, SEQ = 8192, T = BATCH * SEQ, NH = 8, HK = 128, HV = 128;
constexpr int DFF = 2816, NE = 8, INW = 9216;
constexpr int PLD = 4096 + 64;
constexpr float EPS = 1e-6f, QSCALE = 0.08838834764831845f;
constexpr int NS = T + NE * 256;
constexpr int NSTILE = NS / 256;
constexpr int NS2 = 2 * NS, NSTILE2 = NS2 / 256;

constexpr size_t MiB = 1u << 20;
constexpr size_t WS_CTL = 0;
constexpr size_t ZERO_BYTES = 65536;
constexpr size_t OFF_SSQ = 65536;
constexpr size_t OFF_LB = OFF_SSQ + (size_t)4 * T * 16;
constexpr size_t OFF_BLKCNT = OFF_LB + 8192;
constexpr size_t OFF_META = OFF_BLKCNT + 16384;
constexpr size_t OFF_ROUTE = OFF_META + 4096;
constexpr size_t OFF_DEC = OFF_ROUTE;
constexpr size_t OFF_TOK = OFF_ROUTE + (size_t)T * 16;
constexpr size_t OFF_GATE = OFF_TOK + (size_t)2 * NS * 4;
constexpr size_t OFF_RSS = OFF_GATE + (size_t)2 * NS * 4;
static_assert(OFF_RSS + (size_t)2 * NS * 4 <= 4 * MiB && OFF_DEC + (size_t)2048 * 128 * 4 <= 4 * MiB, "ctl region");
constexpr size_t WS_XB = 4 * MiB;
constexpr size_t WS_P = 68 * MiB;
constexpr size_t WS_S = 328 * MiB;
constexpr size_t WS_WNE = 392 * MiB;
constexpr size_t WS_WE = 324 * MiB;
constexpr size_t WS_MRG = 457 * MiB;
constexpr size_t WS_END = 521 * MiB;
constexpr size_t WN_INA = 0;
constexpr size_t WN_INB = WN_INA + (size_t)2 * 4096 * 1024;
constexpr size_t WN_PROJ = WN_INB + (size_t)2 * 5120 * 1024;
constexpr size_t WN_OUT = WN_PROJ + (size_t)2 * 1024 * 2048;
constexpr size_t WN_D13 = WN_OUT + (size_t)2 * 1024 * 1024;
constexpr size_t WN_D2 = WN_D13 + (size_t)5632 * 1024;
constexpr size_t WN_END = WN_D2 + (size_t)1024 * 2816;
static_assert(WN_END * 2 <= 65 * MiB, "wne");
constexpr size_t WE_13 = 0;
constexpr size_t WE_2 = (size_t)8 * 5632 * 1024;
static_assert((WE_2 + (size_t)8 * 1024 * 2816) <= WS_MRG - WS_WE && (size_t)T * PLD * 2 <= WS_S - WS_P, "we / P");
constexpr size_t WS_H = WS_P;
constexpr size_t WS_AG = WS_P + 188 * MiB;
constexpr size_t WS_XB8 = WS_XB;
static_assert((size_t)NS2 * 2816 <= 188 * MiB && WS_AG + (size_t)NS2 * 1024 <= WS_WE, "moe map");

constexpr int CW_TMO = 0, CW_CODE = 1, CW_BAR = 4096;

constexpr int RING_BYTES = 131072;
constexpr int LDSCTL_OFF = RING_BYTES, MISC_OFF = LDSCTL_OFF + 320, RED_OFF = LDSCTL_OFF + 2048;
constexpr int RSCR_OFF = LDSCTL_OFF + 8192;
constexpr int LDS_BYTES = 147456;
constexpr int NWAVES = 8;

namespace pg8 {
constexpr int BM = 256, BK = 64, HALF = 128, HTB = HALF * BK * 2, STAGE_BYTES = 8 * HTB, NXCD = 8, WGM = 8;
__host__ __device__ __forceinline__ int lds_byte(int r, int c) { const int st = (r >> 4) * 2 + (c >> 5), rr = r & 15, cc = c & 31, ob = rr * 64 + cc * 2; return st * 1024 + (ob ^ (((ob >> 9) & 1) << 5)); }
__host__ __device__ __forceinline__ void stage_rc(int b, int& R, int& C) { const int st = b / 1024, sb = b % 1024, swz = sb ^ (((sb >> 9) & 1) << 5); R = (st >> 1) * 16 + swz / 64; C = (st & 1) * 32 + (swz % 64) / 2; }
__host__ __device__ __forceinline__ int perm32(int rho) { const int n = rho >> 4, i = rho & 15; return 8 * (i >> 2) + 4 * n + (i & 3); }

struct Unit { int pm, pn, e; };
struct Gemm { const GAS bf16_t* A; const GAS bf16_t* Bt; int lda; int K; int a_jump; size_t b_estride; };

struct StaticOrder {
    int nM, nN, nwg, G, c;
    __device__ void init(int nM_, int nN_, int G_, int c_) { nM = nM_; nN = nN_; nwg = nM * nN; G = G_; c = c_; }
    __device__ bool next(int i, Unit& u) const {
        const long L = (long)i * G + c; if (L >= nwg) return false;
        int wgid = (int)L; { const int q = nwg / NXCD, r = nwg % NXCD, xcd = wgid % NXCD, off = wgid / NXCD; wgid = (xcd < r ? xcd * (q + 1) : r * (q + 1) + (xcd - r) * q) + off; }
        const int nig = WGM * nN, gid = wgid / nig, fm = gid * WGM, gsz = (nM - fm) < WGM ? (nM - fm) : WGM;
        u.pm = fm + ((wgid % nig) % gsz); u.pn = (wgid % nig) / gsz; u.e = 0; return true;
    }
};
struct MoeOrder {
    StaticOrder so; const LAS unsigned* tile_e; int pm_off;
    __device__ bool next(int i, Unit& u) const {
        if (!so.next(i, u)) return false;
        u.pm += pm_off; u.e = (int)__builtin_amdgcn_readfirstlane(tile_e[u.pm]); return true;
    }
};

__device__ __forceinline__ unsigned cvt_pk_bf16(float lo, float hi) { unsigned r; asm volatile("v_cvt_pk_bf16_f32 %0, %1, %2" : "=v"(r) : "v"(lo), "v"(hi)); return r; }
__device__ __forceinline__ float bf_lo(unsigned w) { return __uint_as_float(w << 16); }
__device__ __forceinline__ float bf_hi(unsigned w) { return __uint_as_float(w & 0xffff0000u); }
__device__ __forceinline__ float sigmoidf_(float v) { return __builtin_amdgcn_rcpf(1.0f + __expf(-v)); }
__device__ __forceinline__ float siluf_(float v) { return v * sigmoidf_(v); }

typedef f32x4 Acc[2][2][4][2];
typedef int i32x4 __attribute__((ext_vector_type(4)));
typedef int i32x8 __attribute__((ext_vector_type(8)));
constexpr int FP8_SCALE_W = 0x79797979, FP8_SCALE_X = 0x7f7f7f7f;

template <class Epi, class Sched, bool FP8 = false>
__device__ __forceinline__ void gemm_phase(LAS unsigned char* lds, const Gemm g, const Sched& S, const Epi& E) {
    int tid_ = threadIdx.x; asm volatile("" : "+v"(tid_));
    const int tid = tid_, wid = __builtin_amdgcn_readfirstlane(tid >> 6), lane = tid & 63, wr = wid >> 2, wc = wid & 3, fr = lane & 15, fq = lane >> 4;
    const int K = g.K, nt = K / BK, th = nt / 2;
    unsigned voffA[2], voffB[2];
#pragma unroll
    for (int i = 0; i < 2; ++i) { int R, C; stage_rc(tid * 16 + i * 8192, R, C); const int Rb = (R & ~31) + perm32(R & 31);
        voffA[i] = (unsigned)(R * g.lda + C) * 2u; voffB[i] = (unsigned)(Rb * K + C) * 2u; }
    const size_t kstep = (size_t)(BK * 2);
    const size_t hstepA = (size_t)HALF * g.lda * 2, tstepA = 2 * hstepA;
    const size_t hstepB = (size_t)HALF * K * 2, tstepB = 2 * hstepB;
    const size_t jump = (size_t)g.a_jump;
    const unsigned ldsw = (unsigned)wid * 1024u;
    const int aoff = FP8 ? lds_byte(wr * 64 + fr, fq * 16) : lds_byte(wr * 64 + fr, fq * 8), boff = FP8 ? lds_byte(wc * 32 + fr, fq * 16) : lds_byte(wc * 32 + fr, fq * 8);
#define PG8_KA(tt) ((size_t)(tt) * kstep + (((tt) >= th) ? jump : (size_t)0))
#define PG8_SA(b, h) (((b) * 2 + (h)) * HTB)
#define PG8_SB(b, h) ((4 + (b) * 2 + (h)) * HTB)
#define PG8_STAGE(bufoff, gbase, voff) do { _Pragma("unroll") for (int _i = 0; _i < 2; ++_i) \
        __builtin_amdgcn_global_load_lds((const GAS unsigned*)((const char*)(gbase) + (voff)[_i]), (LAS unsigned*)(lds + (bufoff) + ldsw + _i * 8192), 16, 0, 0); } while (0)
#define PG8_LDA(dst, b, h) do { if constexpr (FP8) { _Pragma("unroll") for (int m = 0; m < 4; ++m) { const LAS unsigned char* p_ = lds + PG8_SA(b, h) + aoff + m * 2048; \
            dst##8[m] = __builtin_shufflevector(*(const LAS i32x4*)p_, *(const LAS i32x4*)(p_ + 16), 0, 1, 2, 3, 4, 5, 6, 7); } } \
        else { _Pragma("unroll") for (int m = 0; m < 4; ++m) _Pragma("unroll") for (int k = 0; k < 2; ++k) dst[m][k] = *(const LAS bf16x8*)(lds + PG8_SA(b, h) + aoff + m * 2048 + k * 1024); } } while (0)
#define PG8_LDB(dst, b, h) do { if constexpr (FP8) { _Pragma("unroll") for (int n = 0; n < 2; ++n) { const LAS unsigned char* p_ = lds + PG8_SB(b, h) + boff + n * 2048; \
            dst##8[n] = __builtin_shufflevector(*(const LAS i32x4*)p_, *(const LAS i32x4*)(p_ + 16), 0, 1, 2, 3, 4, 5, 6, 7); } } \
        else { _Pragma("unroll") for (int n = 0; n < 2; ++n) _Pragma("unroll") for (int k = 0; k < 2; ++k) dst[n][k] = *(const LAS bf16x8*)(lds + PG8_SB(b, h) + boff + n * 2048 + k * 1024); } } while (0)
#define PG8_MMA(ai, bj, At, Bt) do { __builtin_amdgcn_s_setprio(1); \
        if constexpr (FP8) { _Pragma("unroll") for (int m = 0; m < 4; ++m) _Pragma("unroll") for (int n = 0; n < 2; ++n) \
            asm volatile("v_mfma_scale_f32_16x16x128_f8f6f4 %0, %1, %2, %0, %3, %4 op_sel_hi:[0,0,0]" : "+v"(acc[ai][bj][m][n]) : "v"(Bt##8[n]), "v"(At##8[m]), "v"(fp8_sw), "v"(fp8_sx)); } \
        else { _Pragma("unroll") for (int m = 0; m < 4; ++m) _Pragma("unroll") for (int n = 0; n < 2; ++n) _Pragma("unroll") for (int k = 0; k < 2; ++k) \
            acc[ai][bj][m][n] = __builtin_amdgcn_mfma_f32_16x16x32_bf16(Bt[n][k], At[m][k], acc[ai][bj][m][n], 0, 0, 0); } __builtin_amdgcn_s_setprio(0); } while (0)
#define PG8_WAIT_V(n) asm volatile("s_waitcnt vmcnt(" #n ")" ::: "memory")
#define PG8_WAIT_L(n) asm volatile("s_waitcnt lgkmcnt(" #n ")" ::: "memory")
#define PG8_BAR __builtin_amdgcn_s_barrier()
#define PG8_SCHED __builtin_amdgcn_sched_barrier(0)
    Unit cur, nxt; int ui = 0; int epi_state = -1;
    if (!S.next(0, cur)) return;
    Acc acc;
    if constexpr (Epi::HAS_INIT) E.init(acc, cur, wr, wc, fr, fq);
    else {
#pragma unroll
    for (int a = 0; a < 2; ++a)
#pragma unroll
        for (int b = 0; b < 2; ++b)
#pragma unroll
            for (int m = 0; m < 4; ++m)
#pragma unroll
                for (int n = 0; n < 2; ++n) acc[a][b][m][n] = (f32x4){0.f, 0.f, 0.f, 0.f};
    }
    int fp8_sw = FP8_SCALE_W, fp8_sx = FP8_SCALE_X; if constexpr (FP8) asm volatile("" : "+v"(fp8_sw), "+v"(fp8_sx));
    bf16x8 At[4][2], B0[2][2], B1[2][2]; i32x8 At8[4], B08[2], B18[2];
    const char* cA = (const char*)g.A + (size_t)cur.pm * tstepA; const char* cB = (const char*)g.Bt + ((size_t)cur.e * g.b_estride) * 2 + (size_t)cur.pn * tstepB;
    PG8_STAGE(PG8_SB(0, 0), cB, voffB); PG8_STAGE(PG8_SB(0, 1), cB + hstepB, voffB); PG8_STAGE(PG8_SA(0, 0), cA, voffA); PG8_STAGE(PG8_SA(0, 1), cA + hstepA, voffA);
    if (wr == 1) PG8_BAR;
    PG8_WAIT_V(2); PG8_BAR;
    PG8_STAGE(PG8_SB(1, 0), cB + kstep, voffB); PG8_STAGE(PG8_SA(1, 0), cA + PG8_KA(1), voffA); PG8_STAGE(PG8_SB(1, 1), cB + hstepB + kstep, voffB);
    PG8_WAIT_V(6); PG8_BAR;
    for (;;) {
        const bool has_next = S.next(ui + 1, nxt);
        const char* nA = has_next ? (const char*)g.A + (size_t)nxt.pm * tstepA : cA; const char* nB = has_next ? (const char*)g.Bt + ((size_t)nxt.e * g.b_estride) * 2 + (size_t)nxt.pn * tstepB : cB;
#pragma nounroll
        for (int t = 0; t < nt; t += 2) {
            const bool last = (t == nt - 2);
            const char* a1 = cA + PG8_KA(t + 1);
            const char* a2 = last ? nA : cA + PG8_KA(t + 2); const char* b2 = last ? nB : cB + (size_t)(t + 2) * kstep;
            const char* a3 = last ? nA + PG8_KA(1) : cA + PG8_KA(t + 3); const char* b3 = b2 + kstep;
            if constexpr (Epi::HAS_MID) { if (t == th && !E.skip_mid) E.mid(acc, cur, wr, wc, fr, fq); }
            PG8_LDB(B0, 0, 0); PG8_LDB(B1, 0, 1); PG8_SCHED; PG8_LDA(At, 0, 0); PG8_STAGE(PG8_SA(1, 1), a1 + hstepA, voffA);
            PG8_WAIT_V(8); PG8_WAIT_L(0); PG8_BAR; PG8_MMA(0, 0, At, B0); PG8_MMA(0, 1, At, B1); PG8_BAR; PG8_SCHED;
            PG8_LDA(At, 0, 1); PG8_STAGE(PG8_SB(0, 0), b2, voffB); PG8_STAGE(PG8_SB(0, 1), b2 + hstepB, voffB); PG8_STAGE(PG8_SA(0, 0), a2, voffA);
            PG8_WAIT_V(8); PG8_WAIT_L(0); PG8_BAR; PG8_MMA(1, 0, At, B0); PG8_MMA(1, 1, At, B1); PG8_BAR; PG8_SCHED;
            PG8_LDB(B0, 1, 0); PG8_LDB(B1, 1, 1); PG8_SCHED; PG8_LDA(At, 1, 0); PG8_STAGE(PG8_SA(0, 1), a2 + hstepA, voffA);
            PG8_WAIT_V(8); PG8_WAIT_L(0); PG8_BAR; PG8_MMA(0, 0, At, B0); PG8_MMA(0, 1, At, B1); PG8_BAR; PG8_SCHED;
            PG8_LDA(At, 1, 1); PG8_STAGE(PG8_SB(1, 0), b3, voffB); PG8_STAGE(PG8_SB(1, 1), b3 + hstepB, voffB); PG8_STAGE(PG8_SA(1, 0), a3, voffA);
            PG8_WAIT_V(8); PG8_WAIT_L(0); PG8_BAR; PG8_MMA(1, 0, At, B0); PG8_MMA(1, 1, At, B1); PG8_BAR; PG8_SCHED;
        }
        if constexpr (FP8) asm volatile("s_nop 15\n\ts_nop 15" ::: "memory");
        if (wr == 0) PG8_BAR;
        E(acc, cur, wr, wc, fr, fq, epi_state);
        if (!has_next) break;
        if constexpr (Epi::HAS_INIT) E.init(acc, nxt, wr, wc, fr, fq);
        else {
#pragma unroll
        for (int a = 0; a < 2; ++a)
#pragma unroll
            for (int b = 0; b < 2; ++b)
#pragma unroll
                for (int m = 0; m < 4; ++m)
#pragma unroll
                    for (int n = 0; n < 2; ++n) acc[a][b][m][n] = (f32x4){0.f, 0.f, 0.f, 0.f};
        }
        cur = nxt; cA = nA; cB = nB; ++ui;
        if (wr == 1) PG8_BAR;
    }
    PG8_WAIT_V(0);
    PG8_BAR;
#undef PG8_KA
#undef PG8_SA
#undef PG8_SB
#undef PG8_STAGE
#undef PG8_LDA
#undef PG8_LDB
#undef PG8_MMA
#undef PG8_WAIT_V
#undef PG8_WAIT_L
#undef PG8_BAR
#undef PG8_SCHED
}

constexpr int TBL_OFF = 131072 + 8192;
__device__ __forceinline__ LAS float* epi_tbl() { extern __shared__ __attribute__((aligned(16))) unsigned char lds_[]; return (LAS float*)((LAS unsigned char*)lds_ + TBL_OFF); }
template <int MODE  >
__device__ __forceinline__ void epi_table(const GAS float* src, const GAS int* tok, int pm, int& est) {
    if (pm != est) { est = pm;
        LAS float* tb = epi_tbl(); const int t = threadIdx.x;
        if (t < 256) {
            if (MODE == 0) { const f32x4 p = *(const GAS f32x4*)(src + (size_t)(pm * BM + t) * 4); tb[t] = __builtin_amdgcn_rsqf(((p.x + p.y) + (p.z + p.w)) * (1.0f / 1024.0f) + EPS); }
            if (MODE == 1) tb[t] = src[pm * BM + t];
            if (MODE == 2) { tb[512 + t] = src[pm * BM + t]; ((LAS int*)tb)[256 + t] = tok[pm * BM + t]; } }
        asm volatile("s_waitcnt vmcnt(0) lgkmcnt(0)" ::: "memory"); __builtin_amdgcn_s_barrier(); asm volatile("" ::: "memory"); }
}
__device__ __forceinline__ void load_rstd(int wr, int fr, float (&rs)[2][4]) {
    const LAS float* tb = epi_tbl();
#pragma unroll
    for (int ai = 0; ai < 2; ++ai)
#pragma unroll
        for (int m = 0; m < 4; ++m) rs[ai][m] = tb[ai * HALF + wr * 64 + m * 16 + fr];
}
__device__ __forceinline__ float rstd_of(const GAS float* ssq, int row) { const f32x4 p = *(const GAS f32x4*)(ssq + (size_t)row * 4); return __builtin_amdgcn_rsqf(((p.x + p.y) + (p.z + p.w)) * (1.0f / 1024.0f) + EPS); }
__device__ __forceinline__ u32x2 pack8_fp8(const f32x4 v0, const f32x4 v1) { int a = __builtin_amdgcn_cvt_pk_fp8_f32(v0[0], v0[1], 0, false); a = __builtin_amdgcn_cvt_pk_fp8_f32(v0[2], v0[3], a, true);
    int b = __builtin_amdgcn_cvt_pk_fp8_f32(v1[0], v1[1], 0, false); b = __builtin_amdgcn_cvt_pk_fp8_f32(v1[2], v1[3], b, true); return (u32x2){(unsigned)a, (unsigned)b}; }
__device__ __forceinline__ u32x4 pack8(const f32x4 v0, const f32x4 v1) { u32x4 w; w.x = cvt_pk_bf16(v0[0], v0[1]); w.y = cvt_pk_bf16(v0[2], v0[3]); w.z = cvt_pk_bf16(v1[0], v1[1]); w.w = cvt_pk_bf16(v1[2], v1[3]); return w; }

constexpr float LOG2E = 1.4426950408889634f, LN2 = 0.6931471805599453f;
#define EPI_LAUNDER int fr = fr_, fq = fq_; asm volatile("" : "+v"(fr), "+v"(fq));
struct EpiG1a {
    static constexpr bool HAS_MID = false, HAS_INIT = false;
    GAS bf16_t* P; const GAS float* ssq; const GAS float* LB;
    __device__ __forceinline__ void operator()(const Acc& acc, const Unit& u, int wr, int wc, int fr_, int fq_, int& est) const {
        EPI_LAUNDER
        const int grp = u.pn >> 2, row0 = u.pm * BM + wr * 64 + fr, col0 = u.pn * BM + wc * 32 + 8 * fq;
        {
            const int key = (grp == 1) ? u.pm * 64 + u.pn : u.pm * 64 + 32;
            if (key != est) { est = key; LAS float* tb = epi_tbl(); const int t = threadIdx.x;
                if (t < 256) { const f32x4 p = *(const GAS f32x4*)(ssq + (size_t)(u.pm * BM + t) * 4); tb[t] = __builtin_amdgcn_rsqf(((p.x + p.y) + (p.z + p.w)) * (1.0f / 1024.0f) + EPS);
                    if (grp == 1) tb[768 + t] = LB[(u.pn - 4) * BM + t]; }
                asm volatile("s_waitcnt vmcnt(0) lgkmcnt(0)" ::: "memory"); __builtin_amdgcn_s_barrier(); asm volatile("" ::: "memory"); } }
        float rs[2][4]; load_rstd(wr, fr, rs);
        if (grp == 1) {
            const LAS float* lbp = epi_tbl() + 768 + wc * 32 + 8 * fq;
#pragma unroll
            for (int ai = 0; ai < 2; ++ai)
#pragma unroll
                for (int m = 0; m < 4; ++m) { GAS bf16_t* rowp = P + (size_t)(row0 + ai * HALF + m * 16) * PLD + col0; const float rn = -rs[ai][m] * LOG2E;
#pragma unroll
                    for (int bj = 0; bj < 2; ++bj) { f32x4 o[2];
#pragma unroll
                        for (int n = 0; n < 2; ++n) { const f32x4 lb = *(const LAS f32x4*)(lbp + bj * HALF + 4 * n);
#pragma unroll
                            for (int j = 0; j < 4; ++j) { const float e = __builtin_amdgcn_exp2f(acc[ai][bj][m][n][j] * rn);
                                const float f = __builtin_fmaf(lb[j], e, 1.0f) * __builtin_amdgcn_rcpf(1.0f + e); o[n][j] = LN2 * __builtin_amdgcn_logf(fmaxf(f, 1e-6f)); } }
                        *(GAS u32x4*)(rowp + bj * HALF) = pack8(o[0], o[1]); } }
        } else if (grp == 2) {
#pragma unroll
            for (int ai = 0; ai < 2; ++ai)
#pragma unroll
                for (int m = 0; m < 4; ++m) { GAS bf16_t* rowp = P + (size_t)(row0 + ai * HALF + m * 16) * PLD + col0; const float r = rs[ai][m];
#pragma unroll
                    for (int bj = 0; bj < 2; ++bj) *(GAS u32x4*)(rowp + bj * HALF) = pack8(acc[ai][bj][m][0] * r, acc[ai][bj][m][1] * r); }
        } else {
            const float sc = (grp == 0) ? QSCALE : 1.0f;
#pragma unroll
            for (int ai = 0; ai < 2; ++ai)
#pragma unroll
                for (int m = 0; m < 4; ++m) { GAS bf16_t* rowp = P + (size_t)(row0 + ai * HALF + m * 16) * PLD + col0; const float rn = -rs[ai][m] * LOG2E, r2 = rs[ai][m] * sc;
#pragma unroll
                    for (int bj = 0; bj < 2; ++bj) { f32x4 o[2];
#pragma unroll
                        for (int n = 0; n < 2; ++n)
#pragma unroll
                            for (int j = 0; j < 4; ++j) { const float a = acc[ai][bj][m][n][j]; o[n][j] = (a * r2) * __builtin_amdgcn_rcpf(1.0f + __builtin_amdgcn_exp2f(a * rn)); }
                        *(GAS u32x4*)(rowp + bj * HALF) = pack8(o[0], o[1]); } }
        }
    }
};
struct EpiG1b {
    static constexpr bool HAS_MID = false, HAS_INIT = false;
    GAS bf16_t* P; GAS bf16_t* SB; const GAS float* ssq;
    __device__ __forceinline__ void operator()(const Acc& acc, const Unit& u, int wr, int wc, int fr_, int fq_, int& est) const {
        EPI_LAUNDER
        const int row0 = u.pm * BM + wr * 64 + fr, cw = wc * 32 + 8 * fq;
        epi_table<0>(ssq, nullptr, u.pm, est); float rs[2][4]; load_rstd(wr, fr, rs);
        if (u.pn < 8) {
#pragma unroll
            for (int ai = 0; ai < 2; ++ai)
#pragma unroll
                for (int m = 0; m < 4; ++m) { const float r2 = rs[ai][m] * rs[ai][m];
                    *(GAS u32x4*)(P + (size_t)(row0 + ai * HALF + m * 16) * PLD + 1024 + u.pn * HALF + cw) = pack8(acc[ai][0][m][0] * acc[ai][1][m][0] * r2, acc[ai][0][m][1] * acc[ai][1][m][1] * r2); }
        } else if (u.pn < 12) {
            const int col0 = 2048 + (u.pn - 8) * BM + cw;
#pragma unroll
            for (int ai = 0; ai < 2; ++ai)
#pragma unroll
                for (int m = 0; m < 4; ++m) { GAS bf16_t* rowp = P + (size_t)(row0 + ai * HALF + m * 16) * PLD + col0; const float r = rs[ai][m];
#pragma unroll
                    for (int bj = 0; bj < 2; ++bj) *(GAS u32x4*)(rowp + bj * HALF) = pack8(acc[ai][bj][m][0] * r, acc[ai][bj][m][1] * r); }
        } else {
            const int col0 = (u.pn - 12) * HALF + cw;
#pragma unroll
            for (int ai = 0; ai < 2; ++ai)
#pragma unroll
                for (int m = 0; m < 4; ++m) { const size_t row = (size_t)(row0 + ai * HALF + m * 16); const float rn = -rs[ai][m] * LOG2E; f32x4 o1[2], o2[2];
#pragma unroll
                    for (int n = 0; n < 2; ++n)
#pragma unroll
                        for (int j = 0; j < 4; ++j) { const float ea = __builtin_amdgcn_exp2f(acc[ai][0][m][n][j] * rn), eb = 1.0f + __builtin_amdgcn_exp2f(acc[ai][1][m][n][j] * rn);
                            o1[n][j] = eb * __builtin_amdgcn_rcpf(1.0f + ea); o2[n][j] = __builtin_amdgcn_rcpf(eb); }
                    *(GAS u32x4*)(P + row * PLD + 3072 + col0) = pack8(o1[0], o1[1]); *(GAS u32x4*)(SB + row * 1024 + col0) = pack8(o2[0], o2[1]); }
        }
    }
};
struct EpiG2 {
    static constexpr bool HAS_MID = true, HAS_INIT = false;
    GAS bf16_t* P; const GAS bf16_t* SB; GAS bf16_t* OUT; bool skip_mid;
    __device__ __forceinline__ void mid(Acc& acc, const Unit& u, int wr, int wc, int fr_, int fq_) const {
        EPI_LAUNDER
        const int row0 = u.pm * BM + wr * 64 + fr, col0 = u.pn * BM + wc * 32 + 8 * fq;
        u32x4 g[2][4][2];
#pragma unroll
        for (int ai = 0; ai < 2; ++ai)
#pragma unroll
            for (int m = 0; m < 4; ++m)
#pragma unroll
                for (int bj = 0; bj < 2; ++bj) g[ai][m][bj] = *(const GAS u32x4*)(P + (size_t)(row0 + ai * HALF + m * 16) * PLD + 3072 + col0 + bj * HALF);
        __builtin_amdgcn_sched_barrier(0);
#pragma unroll
        for (int ai = 0; ai < 2; ++ai)
#pragma unroll
            for (int m = 0; m < 4; ++m)
#pragma unroll
                for (int bj = 0; bj < 2; ++bj)
#pragma unroll
                    for (int q = 0; q < 4; ++q) { acc[ai][bj][m][q >> 1][(q & 1) * 2] *= bf_lo(g[ai][m][bj][q]); acc[ai][bj][m][q >> 1][(q & 1) * 2 + 1] *= bf_hi(g[ai][m][bj][q]); }
    }
    __device__ __forceinline__ void operator()(const Acc& acc, const Unit& u, int wr, int wc, int fr_, int fq_, int& est) const {
        EPI_LAUNDER
        const int row0 = u.pm * BM + wr * 64 + fr, col0 = u.pn * BM + wc * 32 + 8 * fq;
        u32x4 g[2][4][2];
#pragma unroll
        for (int ai = 0; ai < 2; ++ai)
#pragma unroll
            for (int m = 0; m < 4; ++m)
#pragma unroll
                for (int bj = 0; bj < 2; ++bj) g[ai][m][bj] = *(const GAS u32x4*)(SB + (size_t)(row0 + ai * HALF + m * 16) * 1024 + col0 + bj * HALF);
        __builtin_amdgcn_sched_barrier(0);
#pragma unroll
        for (int ai = 0; ai < 2; ++ai)
#pragma unroll
            for (int m = 0; m < 4; ++m) { const size_t row = (size_t)(row0 + ai * HALF + m * 16);
#pragma unroll
                for (int bj = 0; bj < 2; ++bj) { f32x4 o[2];
#pragma unroll
                    for (int q = 0; q < 4; ++q) { o[q >> 1][(q & 1) * 2] = acc[ai][bj][m][q >> 1][(q & 1) * 2] * bf_lo(g[ai][m][bj][q]); o[q >> 1][(q & 1) * 2 + 1] = acc[ai][bj][m][q >> 1][(q & 1) * 2 + 1] * bf_hi(g[ai][m][bj][q]); }
                    *(GAS u32x4*)(OUT + row * 1024 + col0 + bj * HALF) = pack8(o[0], o[1]); } }
    }
};
struct EpiRes {
    static constexpr bool HAS_MID = false, HAS_INIT = true;
    GAS float* X; GAS bf16_t* XB; GAS float* ssq_out; LAS float* red; bool dry; bool x8;
    __device__ __forceinline__ void init(Acc& acc, const Unit& u, int wr, int wc, int fr_, int fq_) const {
        EPI_LAUNDER
        const GAS float* xr = X + (size_t)(u.pm * BM + wr * 64 + fr) * 1024 + u.pn * BM + wc * 32 + 8 * fq;
#pragma unroll
        for (int ai = 0; ai < 2; ++ai)
#pragma unroll
            for (int m = 0; m < 4; ++m)
#pragma unroll
                for (int bj = 0; bj < 2; ++bj)
#pragma unroll
                    for (int n = 0; n < 2; ++n) acc[ai][bj][m][n] = *(const GAS f32x4*)(xr + (size_t)(ai * HALF + m * 16) * 1024 + bj * HALF + 4 * n);
    }
    __device__ __forceinline__ void operator()(const Acc& acc, const Unit& u, int wr, int wc, int fr_, int fq_, int& est) const {
        EPI_LAUNDER
        const int row0 = u.pm * BM + wr * 64 + fr, col0 = u.pn * BM + wc * 32 + 8 * fq;
#pragma unroll
        for (int ai = 0; ai < 2; ++ai)
#pragma unroll
            for (int m = 0; m < 4; ++m) { const size_t row = (size_t)(row0 + ai * HALF + m * 16); GAS float* xr = X + row * 1024 + col0; float s = 0.f;
#pragma unroll
                for (int bj = 0; bj < 2; ++bj) { const f32x4 v0 = acc[ai][bj][m][0], v1 = acc[ai][bj][m][1];
                    if (!dry) { *(GAS f32x4*)(xr + bj * HALF) = v0; *(GAS f32x4*)(xr + bj * HALF + 4) = v1; if (x8) *(GAS u32x2*)((GAS unsigned char*)XB + row * 1024 + col0 + bj * HALF) = pack8_fp8(v0, v1); else *(GAS u32x4*)(XB + row * 1024 + col0 + bj * HALF) = pack8(v0, v1); }
                    s += (v0[0] * v0[0] + v0[1] * v0[1]) + (v0[2] * v0[2] + v0[3] * v0[3]) + (v1[0] * v1[0] + v1[1] * v1[1]) + (v1[2] * v1[2] + v1[3] * v1[3]); }
                s += __shfl_xor(s, 16); s += __shfl_xor(s, 32);
                if (fq == 0) red[(ai * HALF + wr * 64 + m * 16 + fr) * 4 + wc] = s; }
        asm volatile("s_waitcnt lgkmcnt(0)" ::: "memory"); __builtin_amdgcn_s_barrier(); asm volatile("" ::: "memory");
        const int t = threadIdx.x;
        if (t < 256 && !dry) { const f32x4 p = *(const LAS f32x4*)(red + t * 4); ssq_out[(size_t)(u.pm * BM + t) * 4 + u.pn] = (p.x + p.y) + (p.z + p.w); }
    }
};
template <bool SLOT> struct EpiSwiglu {
    static constexpr bool HAS_MID = false, HAS_INIT = false;
    GAS bf16_t* H; const GAS float* rsrc; bool cheap;
    __device__ __forceinline__ void operator()(const Acc& acc, const Unit& u, int wr, int wc, int fr_, int fq_, int& est) const {
        EPI_LAUNDER
        const int row0 = u.pm * BM + wr * 64 + fr, col0 = u.pn * HALF + wc * 32 + 8 * fq;
        epi_table<SLOT ? 1 : 0>(rsrc, nullptr, u.pm, est); float rs[2][4]; load_rstd(wr, fr, rs);
#pragma unroll
        for (int ai = 0; ai < 2; ++ai)
#pragma unroll
            for (int m = 0; m < 4; ++m) { const float rn = -rs[ai][m] * LOG2E, r2 = rs[ai][m] * rs[ai][m]; f32x4 o[2];
#pragma unroll
                for (int n = 0; n < 2; ++n)
#pragma unroll
                    for (int j = 0; j < 4; ++j) { const float a = acc[ai][0][m][n][j]; o[n][j] = cheap ? (a * acc[ai][1][m][n][j] * r2) : (a * acc[ai][1][m][n][j] * r2) * __builtin_amdgcn_rcpf(1.0f + __builtin_amdgcn_exp2f(a * rn)); }
                if constexpr (SLOT) *(GAS u32x2*)((GAS unsigned char*)H + (size_t)(row0 + ai * HALF + m * 16) * DFF + col0) = pack8_fp8(o[0], o[1]);
                else *(GAS u32x4*)(H + (size_t)(row0 + ai * HALF + m * 16) * DFF + col0) = pack8(o[0], o[1]); }
    }
};
struct EpiDown {
    static constexpr bool HAS_MID = false, HAS_INIT = false;
    GAS float* X; const GAS int* tok; const GAS float* gate; bool dry;
    __device__ __forceinline__ void operator()(const Acc& acc, const Unit& u, int wr, int wc, int fr_, int fq_, int& est) const {
        EPI_LAUNDER
        const int col0 = u.pn * BM + wc * 32 + 8 * fq;
        epi_table<2>(gate, tok, u.pm, est);
#pragma unroll
        for (int ai = 0; ai < 2; ++ai) {
            int tk[4]; float gt[4]; f32x4 xv[4][2][2];
#pragma unroll
            for (int m = 0; m < 4; ++m) { const int lr = ai * HALF + wr * 64 + m * 16 + fr; tk[m] = ((const LAS int*)epi_tbl())[256 + lr]; gt[m] = epi_tbl()[512 + lr]; }
#pragma unroll
            for (int m = 0; m < 4; ++m) { const GAS float* xr = X + (size_t)(tk[m] < 0 ? 0 : tk[m]) * 1024 + col0;
#pragma unroll
                for (int bj = 0; bj < 2; ++bj) { xv[m][bj][0] = *(const GAS f32x4*)(xr + bj * HALF); xv[m][bj][1] = *(const GAS f32x4*)(xr + bj * HALF + 4); } }
            __builtin_amdgcn_sched_barrier(0);
#pragma unroll
            for (int m = 0; m < 4; ++m) if (tk[m] >= 0 && !dry) { GAS float* xr = X + (size_t)tk[m] * 1024 + col0;
#pragma unroll
                for (int bj = 0; bj < 2; ++bj) { *(GAS f32x4*)(xr + bj * HALF) = xv[m][bj][0] + acc[ai][bj][m][0] * gt[m]; *(GAS f32x4*)(xr + bj * HALF + 4) = xv[m][bj][1] + acc[ai][bj][m][1] * gt[m]; } }
        }
    }
};
}

#define XB_TMO      128
#define XB_XCNT(j)  (256  + 64 * (j))
#define XB_XSUB(j)  (1280 + 64 * (j))
#define XB_XGEN(j)  (2304 + 64 * (j))
#define XB_TOP      3328
#define XB_TOPGEN   3392
#define XCD_BAR_WORDS 3456
#define XB_SPIN_CAP (1u << 18)
__device__ __forceinline__ unsigned xb_ld(unsigned* p)              { return __hip_atomic_load(p, __ATOMIC_RELAXED, __HIP_MEMORY_SCOPE_AGENT); }
__device__ __forceinline__ unsigned xb_add(unsigned* p, unsigned v) { return __hip_atomic_fetch_add(p, v, __ATOMIC_RELAXED, __HIP_MEMORY_SCOPE_AGENT); }
__device__ __forceinline__ unsigned xb_xcc_id() { return (unsigned)__builtin_amdgcn_s_getreg((3 << 11) | 20) & 0xFu; }
#define XB_SPIN(cond, bar) do { unsigned _sp = 0; while (cond) { __builtin_amdgcn_s_sleep(1); \
    if ((++_sp & 255u) == 0u) { if (xb_ld(&(bar)[XB_TMO])) break; if (_sp > XB_SPIN_CAP) { atomicAdd(&(bar)[XB_TMO], 1u); break; } } } } while (0)
struct XcdBarrier { unsigned* bar; unsigned x; volatile LAS unsigned* st; };
__device__ __forceinline__ XcdBarrier xcd_barrier_post(unsigned* bar, volatile LAS unsigned* st) {
    XcdBarrier b; b.bar = bar; b.x = xb_xcc_id(); b.st = st;
    if (threadIdx.x == 0) (void)xb_add(&bar[XB_XCNT(b.x)], 1u);
    return b;
}
__device__ __forceinline__ void xcd_barrier_complete(unsigned* bar, unsigned x, unsigned& nloc, unsigned& nx) {
    const unsigned G = gridDim.x * gridDim.y * gridDim.z;
    unsigned sum, cnt, mine, sp = 0u;
    for (;;) {
        sum = 0u; cnt = 0u; mine = 0u;
#pragma unroll
        for (unsigned j = 0; j < 16; ++j) { const unsigned c = xb_ld(&bar[XB_XCNT(j)]); sum += c; cnt += (c > 0u) ? 1u : 0u; mine = (j == x) ? c : mine; }
        if (sum == G) break;
        __builtin_amdgcn_s_sleep(1);
        if ((++sp & 255u) == 0u) { if (xb_ld(&bar[XB_TMO])) break; if (sp > XB_SPIN_CAP) { atomicAdd(&bar[XB_TMO], 1u); break; } }
    }
    nloc = mine > 0u ? mine : 1u; nx = cnt > 0u ? cnt : 1u;
}
__device__ __forceinline__ void xcd_barrier(const XcdBarrier& b) {
    asm volatile("s_waitcnt vmcnt(0)" ::: "memory");
    __syncthreads();
    if (threadIdx.x == 0) {
        unsigned* bar = b.bar;
        __builtin_amdgcn_s_waitcnt(0);
        unsigned nloc = b.st[0], nx = b.st[1];
        if (nloc == 0u) { xcd_barrier_complete(bar, b.x, nloc, nx); b.st[0] = nloc; b.st[1] = nx; }
        const unsigned old = xb_add(&bar[XB_XSUB(b.x)], 1u);
        const unsigned gen = old / nloc;
        if (old + 1u == (gen + 1u) * nloc) {
            __builtin_amdgcn_fence(__ATOMIC_RELEASE, "agent");
            asm volatile("s_waitcnt vmcnt(0)" ::: "memory");
            const unsigned og = xb_add(&bar[XB_TOP], 1u);
            const unsigned tg = og / nx;
            if (og + 1u == (tg + 1u) * nx) xb_add(&bar[XB_TOPGEN], 1u);
            else XB_SPIN(xb_ld(&bar[XB_TOPGEN]) == tg, bar);
            __builtin_amdgcn_fence(__ATOMIC_ACQUIRE, "agent");
            xb_add(&bar[XB_XGEN(b.x)], 1u);
            asm volatile("s_waitcnt vmcnt(0)" ::: "memory");
        } else {
            XB_SPIN(xb_ld(&bar[XB_XGEN(b.x)]) == gen, bar);
            __builtin_amdgcn_fence(__ATOMIC_ACQUIRE, "agent");
            asm volatile("s_waitcnt vmcnt(0)" ::: "memory");
        }
    }
    __syncthreads();
}

struct Frame {
    LAS unsigned char* lds; volatile LAS unsigned* MISC;
    int tid, lane, wave, vcu, G, rot;
    GAS unsigned char* ws; GAS float* X;
    const GAS float* const* in;
};
#define LDS_WAIT() asm volatile("s_waitcnt lgkmcnt(0)" ::: "memory")
__device__ __forceinline__ float wave_sum(float v) {
#pragma unroll
    for (int o = 1; o < 64; o <<= 1) v += __shfl_xor(v, o);
    return v;
}
__device__ __forceinline__ unsigned f2bf(float f) { unsigned u = __builtin_bit_cast(unsigned, f); return (u + 0x7fffu + ((u >> 16) & 1u)) >> 16; }
__device__ __forceinline__ unsigned pk2(float lo, float hi) { return f2bf(lo) | (f2bf(hi) << 16); }
__device__ __forceinline__ float bf2f(bf16_t b) { return __uint_as_float(((unsigned)b) << 16); }

struct Job { const GAS float* src; int ldsrc, K, ncb, c0; GAS bf16_t* dst; int lddst, dk0, kind, base; const GAS float* scale; int fp8; };
__device__ __forceinline__ void transpose_item(const Job& j, int item, LAS unsigned char* scr, int lane) {
    const int ncb64 = j.ncb >> 1, kb = item / ncb64, nb = item % ncb64, k0 = 64 * kb, cl = 64 * nb;
    const int drow0 = (j.kind == 0) ? j.base + cl : 256 * (cl >> 7) + (cl & 127) + j.base;
    const int cg = lane & 15, rq = lane >> 4;
    f32x4 v[16];
    const GAS float* sp = j.src + (size_t)(k0 + 16 * rq) * j.ldsrc + j.c0 + cl + 4 * cg;
#pragma unroll
    for (int i = 0; i < 16; ++i) v[i] = *(const GAS f32x4*)(sp + (size_t)i * j.ldsrc);
    if (j.scale) {
#pragma unroll
        for (int i = 0; i < 16; ++i) v[i] = v[i] * j.scale[k0 + 16 * rq + i]; }
    if (j.fp8) {
#pragma unroll
        for (int c = 0; c < 4; ++c) { const int n = 4 * cg + c; int w[4];
#pragma unroll
            for (int q = 0; q < 4; ++q) { int a = __builtin_amdgcn_cvt_pk_fp8_f32(v[4 * q][c] * 64.0f, v[4 * q + 1][c] * 64.0f, 0, false); w[q] = __builtin_amdgcn_cvt_pk_fp8_f32(v[4 * q + 2][c] * 64.0f, v[4 * q + 3][c] * 64.0f, a, true); }
            *(LAS u32x4*)(scr + n * 80 + ((rq ^ ((cg >> 1) & 3)) << 4)) = (u32x4){(unsigned)w[0], (unsigned)w[1], (unsigned)w[2], (unsigned)w[3]}; }
        LDS_WAIT(); asm volatile("" ::: "memory");
        const int L4 = lane & 3;
#pragma unroll
        for (int jj = 0; jj < 4; ++jj) { const int n = (lane >> 2) + 16 * jj;
            const u32x4 o = *(const LAS u32x4*)(scr + n * 80 + ((L4 ^ ((n >> 3) & 3)) << 4));
            *(GAS u32x4*)((GAS unsigned char*)j.dst + (size_t)(drow0 + n) * j.lddst + j.dk0 + k0 + 16 * L4) = o; }
        LDS_WAIT(); asm volatile("" ::: "memory");
        return;
    }
#pragma unroll
    for (int c = 0; c < 4; ++c) { const int n = 4 * cg + c;
        const u32x4 lo = (u32x4){pk2(v[0][c], v[1][c]), pk2(v[2][c], v[3][c]), pk2(v[4][c], v[5][c]), pk2(v[6][c], v[7][c])};
        const u32x4 hi = (u32x4){pk2(v[8][c], v[9][c]), pk2(v[10][c], v[11][c]), pk2(v[12][c], v[13][c]), pk2(v[14][c], v[15][c])};
        *(LAS u32x4*)(scr + n * 128 + (((2 * rq) ^ (cg & 7)) << 4)) = lo; *(LAS u32x4*)(scr + n * 128 + (((2 * rq + 1) ^ (cg & 7)) << 4)) = hi; }
    LDS_WAIT(); asm volatile("" ::: "memory");
    const int L = lane & 7;
#pragma unroll
    for (int jj = 0; jj < 8; ++jj) { const int n = (lane >> 3) + 8 * jj;
        const u32x4 o = *(const LAS u32x4*)(scr + n * 128 + ((L ^ ((n >> 2) & 7)) << 4));
        *(GAS u32x4*)(j.dst + (size_t)(drow0 + n) * j.lddst + j.dk0 + k0 + 8 * L) = o; }
    LDS_WAIT(); asm volatile("" ::: "memory");
}
__device__ __forceinline__ void run_job(Frame& F, const Job& j) {
    LAS unsigned char* scr = F.lds + F.wave * 8192;
    const int gw = F.vcu * NWAVES + F.wave, NGW = F.G * NWAVES, nit = (j.K / 64) * (j.ncb >> 1);
    int first = gw - F.rot; if (first < 0) first += NGW;
    for (int it = first; it < nit; it += NGW) transpose_item(j, it, scr, F.lane);
    F.rot = (F.rot + nit) % NGW;
}
enum { I_X = 0, I_WIN, I_LB, I_GNW, I_CONVW, I_WPH, I_WPC, I_WOUT, I_NMIX, I_NFFN, I_DW1, I_DW3, I_DW2, I_RW, I_EW1, I_EW3, I_EW2, I_FN };

__device__ __forceinline__ void p_prologue(Frame& F) {
    F.rot = 0;
    GAS bf16_t* W = (GAS bf16_t*)(F.ws + WS_WNE);
    for (int L = 0; L < 2; ++L) {
        const GAS float* win = F.in[I_WIN] + (size_t)L * D * INW; const GAS float* nm = F.in[I_NMIX] + L * D;
        GAS bf16_t* wa = W + WN_INA + (size_t)L * 4096 * 1024; GAS bf16_t* wb = W + WN_INB + (size_t)L * 5120 * 1024;
        run_job(F, Job{win, INW, D, 128, 0, wa, 1024, 0, 0, 0, nm, 0});
        run_job(F, Job{win, INW, D, 32, 4096, wb, 1024, 0, 1, 0, nm, 0});
        run_job(F, Job{win, INW, D, 32, 6144, wb, 1024, 0, 1, 128, nm, 0});
        run_job(F, Job{win, INW, D, 32, 5120, wb, 1024, 0, 0, 2048, nm, 0});
        run_job(F, Job{win, INW, D, 32, 7168, wb, 1024, 0, 1, 3072, nm, 0});
        run_job(F, Job{win, INW, D, 32, 8192, wb, 1024, 0, 1, 3072 + 128, nm, 0});
        GAS bf16_t* wp = W + WN_PROJ + (size_t)L * 1024 * 2048;
        run_job(F, Job{F.in[I_WPH] + (size_t)L * D * D, D, D, 32, 0, wp, 2048, 0, 0, 0, nullptr, 0});
        run_job(F, Job{F.in[I_WPC] + (size_t)L * D * D, D, D, 32, 0, wp, 2048, 1024, 0, 0, nullptr, 0});
        run_job(F, Job{F.in[I_WOUT] + (size_t)L * D * D, D, D, 32, 0, W + WN_OUT + (size_t)L * D * D, 1024, 0, 0, 0, nullptr, 0});
    }
    run_job(F, Job{F.in[I_DW1], DFF, D, 88, 0, W + WN_D13, 1024, 0, 1, 0, F.in[I_NFFN], 0});
    run_job(F, Job{F.in[I_DW3], DFF, D, 88, 0, W + WN_D13, 1024, 0, 1, 128, F.in[I_NFFN], 0});
    run_job(F, Job{F.in[I_DW2], D, DFF, 32, 0, W + WN_D2, DFF, 0, 0, 0, nullptr, 0});
    const int gw = F.vcu * NWAVES + F.wave, NGW = F.G * NWAVES;
    GAS f32x4* ssq0 = (GAS f32x4*)(F.ws + OFF_SSQ); GAS bf16_t* XB = (GAS bf16_t*)(F.ws + WS_XB);
    for (int m = gw; m < T; m += NGW) {
        const GAS f32x4* xr = (const GAS f32x4*)(F.in[I_X] + (size_t)m * D) + F.lane; GAS f32x4* xo = (GAS f32x4*)(F.X + (size_t)m * D) + F.lane;
        GAS unsigned long long* o8 = (GAS unsigned long long*)(XB + (size_t)m * D) + F.lane; float s = 0.f;
#pragma unroll
        for (int j = 0; j < 4; ++j) { const f32x4 v = xr[64 * j]; xo[64 * j] = v; s += (v.x * v.x + v.y * v.y) + (v.z * v.z + v.w * v.w);
            o8[64 * j] = (unsigned long long)pk2(v.x, v.y) | ((unsigned long long)pk2(v.z, v.w) << 32); }
        s = wave_sum(s); if (F.lane == 0) ssq0[m] = (f32x4){s, 0.f, 0.f, 0.f};
    }
    if (blockIdx.x == 0) { GAS float* LBp = (GAS float*)(F.ws + OFF_LB);
        for (int c = F.tid; c < 1024; c += NWAVES * 64) { const float l0 = F.in[I_LB][c], l1 = F.in[I_LB][1024 + c]; LBp[c] = 0.f; LBp[1024 + c] = 1.0f / (1.0f + __expf(l0 - l1)); } }
}
__device__ __forceinline__ void p_convert_experts(Frame& F) {
    F.rot = 0;
    GAS unsigned char* W = F.ws + WS_WE; const GAS float* nf = F.in[I_NFFN] + D;
    for (int e = 0; e < NE; ++e) {
        GAS bf16_t* w13 = (GAS bf16_t*)(W + WE_13 + (size_t)e * 5632 * 1024);
        run_job(F, Job{F.in[I_EW1] + (size_t)e * D * DFF, DFF, D, 88, 0, w13, 1024, 0, 1, 0, nf, 1});
        run_job(F, Job{F.in[I_EW3] + (size_t)e * D * DFF, DFF, D, 88, 0, w13, 1024, 0, 1, 128, nf, 1});
        run_job(F, Job{F.in[I_EW2] + (size_t)e * DFF * D, D, DFF, 32, 0, (GAS bf16_t*)(W + WE_2 + (size_t)e * 1024 * DFF), DFF, 0, 0, 0, nullptr, 1});
    }
}
__device__ __forceinline__ void p_scan(Frame& F) {
    const GAS bf16_t* P = (const GAS bf16_t*)(F.ws + WS_P); GAS bf16_t* O = (GAS bf16_t*)(F.ws + WS_S);
    LAS f32x2* LQ = (LAS f32x2*)(F.lds);
    LAS float* IV = (LAS float*)(F.lds + 16384);
    LAS float* PART = (LAS float*)(F.lds + 16384 + 1024);
    const int tid = F.tid, k = tid >> 2, vq = tid & 3;
    for (int wi = F.vcu; wi < 256; wi += F.G) {
        const int bh = wi >> 3, vs = wi & 7, b = bh >> 3, h = bh & 7;
        const size_t rbase = (size_t)b * SEQ;
        const int lr = tid >> 5, lk = (tid & 31) * 4;
        float S0 = 0.f, S1 = 0.f, S2 = 0.f, S3 = 0.f;
        u32x2 rq, rf, rv = (u32x2){0u, 0u};
        { const GAS bf16_t* rp = P + (rbase + lr) * PLD + h * 128; rq = *(const GAS u32x2*)(rp + lk); rf = *(const GAS u32x2*)(rp + 1024 + lk);
          if (tid < 64) rv = *(const GAS u32x2*)(P + (rbase + (tid >> 2)) * PLD + 2048 + h * 128 + vs * 16 + (tid & 3) * 4); }
        for (int t0 = 0; t0 < SEQ; t0 += 16) {
            LQ[lr * 128 + lk + 0] = (f32x2){pg8::bf_lo(rf.x), pg8::bf_lo(rq.x)}; LQ[lr * 128 + lk + 1] = (f32x2){pg8::bf_hi(rf.x), pg8::bf_hi(rq.x)};
            LQ[lr * 128 + lk + 2] = (f32x2){pg8::bf_lo(rf.y), pg8::bf_lo(rq.y)}; LQ[lr * 128 + lk + 3] = (f32x2){pg8::bf_hi(rf.y), pg8::bf_hi(rq.y)};
            if (tid < 64) { LAS float* iv = IV + (tid >> 2) * 16 + (tid & 3) * 4; iv[0] = pg8::bf_lo(rv.x); iv[1] = pg8::bf_hi(rv.x); iv[2] = pg8::bf_lo(rv.y); iv[3] = pg8::bf_hi(rv.y); }
            __syncthreads();
            if (t0 + 16 < SEQ) { const GAS bf16_t* rp = P + (rbase + t0 + 16 + lr) * PLD + h * 128; rq = *(const GAS u32x2*)(rp + lk); rf = *(const GAS u32x2*)(rp + 1024 + lk);
                if (tid < 64) rv = *(const GAS u32x2*)(P + (rbase + t0 + 16 + (tid >> 2)) * PLD + 2048 + h * 128 + vs * 16 + (tid & 3) * 4); }
#pragma unroll 4
            for (int tt = 0; tt < 16; ++tt) {
                const f32x2 lq = LQ[tt * 128 + k]; const f32x4 iv = *(const LAS f32x4*)(IV + tt * 16 + vq * 4);
                const float f = __expf(lq.x), kk = 1.0f - f, q = lq.y;
                S0 = f * S0 + kk * iv.x; S1 = f * S1 + kk * iv.y; S2 = f * S2 + kk * iv.z; S3 = f * S3 + kk * iv.w;
                float p0 = q * S0, p1 = q * S1, p2 = q * S2, p3 = q * S3;
#pragma unroll
                for (int o = 4; o < 64; o <<= 1) { p0 += __shfl_xor(p0, o); p1 += __shfl_xor(p1, o); p2 += __shfl_xor(p2, o); p3 += __shfl_xor(p3, o); }
                if ((F.lane >> 2) == 0) *(LAS f32x4*)(PART + (tt * 8 + F.wave) * 16 + vq * 4) = (f32x4){p0, p1, p2, p3};
            }
            __syncthreads();
            if (tid < 256) { const int tt = tid >> 4, v = tid & 15; float s = 0.f;
#pragma unroll
                for (int w = 0; w < 8; ++w) s += PART[(tt * 8 + w) * 16 + v];
                O[(rbase + t0 + tt) * 1024 + h * 128 + vs * 16 + v] = (bf16_t)f2bf(s); }
        }
        __syncthreads();
    }
}
typedef float f32x16 __attribute__((ext_vector_type(16)));
typedef __bf16 bfx2_t __attribute__((ext_vector_type(2)));
#define MFMA32(a, b, c) __builtin_amdgcn_mfma_f32_32x32x16_bf16((a), (b), (c), 0, 0, 0)
__device__ __forceinline__ unsigned pkbf(float a, float b) { const f32x2 v = {a, b}; const bfx2_t r = __builtin_convertvector(v, bfx2_t); return __builtin_bit_cast(unsigned, r); }
__device__ __forceinline__ int img_off(int row, int ch) { return 256 * row + 16 * (ch ^ (((row & 3) << 2) | ((row >> 2) & 3))); }
__device__ __forceinline__ bf16x8 ldfrag(const LAS unsigned char* tile, int row, int ch) { return *(const LAS bf16x8*)(tile + img_off(row, ch)); }

__device__ __forceinline__ void p_r1(Frame& F) {
    const GAS bf16_t* P = (const GAS bf16_t*)(F.ws + WS_P); GAS bf16_t* ST = (GAS bf16_t*)(F.ws + WS_S); GAS float* DEC = (GAS float*)(F.ws + OFF_DEC);
    LAS unsigned char* KT = F.lds; LAS unsigned char* VT = F.lds + 32768; LAS f32x2* GT = (LAS f32x2*)(F.lds + RSCR_OFF);
    const int kp = F.lane, th = F.wave, r = F.lane & 31, hh = F.lane >> 5;
    for (int it = F.vcu; it < 2048; it += F.G) {
        const int bh = it >> 6, c = it & 63, b = bh >> 3, h = bh & 7;
        const GAS bf16_t* base = P + ((size_t)b * SEQ + c * 128 + 16 * th) * PLD + h * 128 + 2 * kp;
        unsigned lf2[16], iv2[16];
#pragma unroll
        for (int i = 0; i < 16; ++i) { lf2[i] = *(const GAS unsigned*)(base + (size_t)i * PLD + 1024); iv2[i] = *(const GAS unsigned*)(base + (size_t)i * PLD + 2048); }
        float c0[16], c1[16]; float a0 = 0.f, a1 = 0.f;
#pragma unroll
        for (int i = 0; i < 16; ++i) { a0 += pg8::bf_lo(lf2[i]); a1 += pg8::bf_hi(lf2[i]); c0[i] = a0; c1[i] = a1; }
        GT[th * 64 + kp] = (f32x2){a0, a1};
        __syncthreads();
        float o0 = 0.f, o1 = 0.f, t0 = 0.f, t1 = 0.f;
#pragma unroll
        for (int g = 0; g < 8; ++g) { const f32x2 v = GT[g * 64 + kp]; if (g < th) { o0 += v.x; o1 += v.y; } t0 += v.x; t1 += v.y; }
        unsigned k0p[8], k1p[8];
#pragma unroll
        for (int i = 0; i < 16; i += 2) {
            const float ka0 = (1.0f - __expf(pg8::bf_lo(lf2[i]))) * __expf(t0 - (o0 + c0[i])), kb0 = (1.0f - __expf(pg8::bf_lo(lf2[i + 1]))) * __expf(t0 - (o0 + c0[i + 1]));
            const float ka1 = (1.0f - __expf(pg8::bf_hi(lf2[i]))) * __expf(t1 - (o1 + c1[i])), kb1 = (1.0f - __expf(pg8::bf_hi(lf2[i + 1]))) * __expf(t1 - (o1 + c1[i + 1]));
            k0p[i >> 1] = pkbf(ka0, kb0); k1p[i >> 1] = pkbf(ka1, kb1); }
        *(LAS u32x4*)(KT + img_off(2 * kp, 2 * th)) = (u32x4){k0p[0], k0p[1], k0p[2], k0p[3]}; *(LAS u32x4*)(KT + img_off(2 * kp, 2 * th + 1)) = (u32x4){k0p[4], k0p[5], k0p[6], k0p[7]};
        *(LAS u32x4*)(KT + img_off(2 * kp + 1, 2 * th)) = (u32x4){k1p[0], k1p[1], k1p[2], k1p[3]}; *(LAS u32x4*)(KT + img_off(2 * kp + 1, 2 * th + 1)) = (u32x4){k1p[4], k1p[5], k1p[6], k1p[7]};
        unsigned v0p[8], v1p[8];
#pragma unroll
        for (int i = 0; i < 16; i += 2) { v0p[i >> 1] = (iv2[i] & 0xffffu) | (iv2[i + 1] << 16); v1p[i >> 1] = (iv2[i] >> 16) | (iv2[i + 1] & 0xffff0000u); }
        *(LAS u32x4*)(VT + img_off(2 * kp, 2 * th)) = (u32x4){v0p[0], v0p[1], v0p[2], v0p[3]}; *(LAS u32x4*)(VT + img_off(2 * kp, 2 * th + 1)) = (u32x4){v0p[4], v0p[5], v0p[6], v0p[7]};
        *(LAS u32x4*)(VT + img_off(2 * kp + 1, 2 * th)) = (u32x4){v1p[0], v1p[1], v1p[2], v1p[3]}; *(LAS u32x4*)(VT + img_off(2 * kp + 1, 2 * th + 1)) = (u32x4){v1p[4], v1p[5], v1p[6], v1p[7]};
        if (th == 0) *(GAS f32x2*)(DEC + (size_t)it * 128 + 2 * kp) = (f32x2){__expf(t0), __expf(t1)};
        __syncthreads();
        const int ktile = th >> 1, vt0 = (th & 1) * 2;
        f32x16 acc0, acc1;
#pragma unroll
        for (int i = 0; i < 16; ++i) { acc0[i] = 0.f; acc1[i] = 0.f; }
#pragma unroll
        for (int ks = 0; ks < 8; ++ks) { const bf16x8 a = ldfrag(KT, 32 * ktile + r, 2 * ks + hh), b0 = ldfrag(VT, 32 * vt0 + r, 2 * ks + hh), b1 = ldfrag(VT, 32 * vt0 + 32 + r, 2 * ks + hh);
            acc0 = MFMA32(a, b0, acc0); acc1 = MFMA32(a, b1, acc1); }
        GAS bf16_t* o = ST + (size_t)it * 16384 + 32 * ktile + 4 * hh;
#pragma unroll
        for (int g = 0; g < 4; ++g) {
            *(GAS u32x2*)(o + (size_t)(32 * vt0 + r) * 128 + 8 * g) = (u32x2){pkbf(acc0[4 * g], acc0[4 * g + 1]), pkbf(acc0[4 * g + 2], acc0[4 * g + 3])};
            *(GAS u32x2*)(o + (size_t)(32 * vt0 + 32 + r) * 128 + 8 * g) = (u32x2){pkbf(acc1[4 * g], acc1[4 * g + 1]), pkbf(acc1[4 * g + 2], acc1[4 * g + 3])}; }
        __syncthreads();
    }
}
__device__ __forceinline__ void p_r2(Frame& F, bool dry) {
    GAS bf16_t* ST = (GAS bf16_t*)(F.ws + WS_S); const GAS float* DEC = (const GAS float*)(F.ws + OFF_DEC);
    for (int q = F.vcu * (NWAVES * 64) + F.tid; q < 32 * 4096; q += F.G * NWAVES * 64) {
        const int bh = q >> 12, e4 = q & 4095, v = e4 >> 5, k4 = (e4 & 31) * 4;
        GAS bf16_t* p = ST + (size_t)bh * 64 * 16384 + v * 128 + k4; const GAS float* d = DEC + (size_t)bh * 64 * 128 + k4;
        float S0 = 0.f, S1 = 0.f, S2 = 0.f, S3 = 0.f;
        for (int c0 = 0; c0 < 64; c0 += 8) {
            u32x2 ds[8]; f32x4 dd[8];
#pragma unroll
            for (int j = 0; j < 8; ++j) { ds[j] = *(const GAS u32x2*)(p + (size_t)(c0 + j) * 16384); dd[j] = *(const GAS f32x4*)(d + (size_t)(c0 + j) * 128); }
#pragma unroll
            for (int j = 0; j < 8; ++j) { if (!dry) *(GAS u32x2*)(p + (size_t)(c0 + j) * 16384) = (u32x2){pkbf(S0, S1), pkbf(S2, S3)};
                S0 = dd[j].x * S0 + pg8::bf_lo(ds[j].x); S1 = dd[j].y * S1 + pg8::bf_hi(ds[j].x); S2 = dd[j].z * S2 + pg8::bf_lo(ds[j].y); S3 = dd[j].w * S3 + pg8::bf_hi(ds[j].y); }
        }
    }
}
__device__ __forceinline__ void p_r3(Frame& F, int L, bool dry) {
    GAS bf16_t* P = (GAS bf16_t*)(F.ws + WS_P); const GAS bf16_t* ST = (const GAS bf16_t*)(F.ws + WS_S); const GAS float* gw = F.in[I_GNW] + L * HV;
    LAS unsigned char* QD = F.lds; LAS unsigned char* KD = F.lds + 32768; LAS unsigned char* QB = F.lds + 65536; LAS unsigned char* KB = F.lds + 81920; LAS unsigned char* VT = F.lds + 98304;
    LAS f32x2* GT = (LAS f32x2*)(F.lds + RSCR_OFF); LAS float* EV = (LAS float*)(F.lds + RSCR_OFF + 4096); LAS float* NP = (LAS float*)(F.lds + RSCR_OFF + 5120);
    const int kp = F.lane, th = F.wave, r = F.lane & 31, hh = F.lane >> 5;
    const int tb = (th < 4) ? th : 7 - th, vh = th >> 2, subt = tb >> 1;
    for (int it = F.vcu; it < 2048; it += F.G) {
        const int bh = it >> 6, c = it & 63, b = bh >> 3, h = bh & 7;
        const size_t rowc = (size_t)b * SEQ + c * 128;
        {
            const GAS bf16_t* base = P + (rowc + 16 * th) * PLD + h * 128 + 2 * kp;
            unsigned lf2[16], q2[16], iv2[16];
#pragma unroll
            for (int i = 0; i < 16; ++i) { q2[i] = *(const GAS unsigned*)(base + (size_t)i * PLD); lf2[i] = *(const GAS unsigned*)(base + (size_t)i * PLD + 1024); iv2[i] = *(const GAS unsigned*)(base + (size_t)i * PLD + 2048); }
            float c0[16], c1[16]; float a0 = 0.f, a1 = 0.f;
#pragma unroll
            for (int i = 0; i < 16; ++i) { a0 += pg8::bf_lo(lf2[i]); a1 += pg8::bf_hi(lf2[i]); c0[i] = a0; c1[i] = a1; }
            GT[th * 64 + kp] = (f32x2){a0, a1};
            __syncthreads();
            float o0 = 0.f, o1 = 0.f, r00 = 0.f, r01 = 0.f, m0 = 0.f, m1 = 0.f, r10 = 0.f, r11 = 0.f;
#pragma unroll
            for (int g = 0; g < 6; ++g) { const f32x2 v = GT[g * 64 + kp]; if (g < th) { o0 += v.x; o1 += v.y; } if (g < 2) { r00 += v.x; r01 += v.y; } if (g < 4) { m0 += v.x; m1 += v.y; } r10 += v.x; r11 += v.y; }
            { const f32x2 v = GT[6 * 64 + kp]; if (6 < th) { o0 += v.x; o1 += v.y; } }
            const bool sub = th >= 4; const float rd0 = sub ? r10 : r00, rd1 = sub ? r11 : r01;
            const int chq = kp >> 2, inq = (kp & 3) * 4;
#pragma unroll
            for (int i = 0; i < 16; ++i) {
                const int t = 16 * th + i;
                const float cu0 = o0 + c0[i], cu1 = o1 + c1[i];
                const float kk0 = 1.0f - __expf(pg8::bf_lo(lf2[i])), kk1 = 1.0f - __expf(pg8::bf_hi(lf2[i])), q0 = pg8::bf_lo(q2[i]), q1 = pg8::bf_hi(q2[i]);
                const unsigned qd = pkbf(q0 * __expf(fminf(cu0 - rd0, 80.f)), q1 * __expf(fminf(cu1 - rd1, 80.f)));
                const unsigned kd = pkbf(kk0 * __expf(fminf(rd0 - cu0, 80.f)), kk1 * __expf(fminf(rd1 - cu1, 80.f)));
                *(LAS unsigned*)(QD + img_off(t, chq) + inq) = qd; *(LAS unsigned*)(KD + img_off(t, chq) + inq) = kd;
                if (sub) *(LAS unsigned*)(QB + img_off(t - 64, chq) + inq) = pkbf(q0 * __expf(cu0 - m0), q1 * __expf(cu1 - m1));
                else     *(LAS unsigned*)(KB + img_off(t, chq) + inq) = pkbf(kk0 * __expf(m0 - cu0), kk1 * __expf(m1 - cu1));
            }
            unsigned v0p[8], v1p[8];
#pragma unroll
            for (int a = 0; a < 2; ++a)
#pragma unroll
                for (int e = 0; e < 4; ++e) { const int i0 = (e < 2 ? 0 : 8) + 4 * a + 2 * (e & 1);
                    v0p[4 * a + e] = (iv2[i0] & 0xffffu) | (iv2[i0 + 1] << 16); v1p[4 * a + e] = (iv2[i0] >> 16) | (iv2[i0 + 1] & 0xffff0000u); }
            *(LAS u32x4*)(VT + img_off(2 * kp, 2 * th)) = (u32x4){v0p[0], v0p[1], v0p[2], v0p[3]}; *(LAS u32x4*)(VT + img_off(2 * kp, 2 * th + 1)) = (u32x4){v0p[4], v0p[5], v0p[6], v0p[7]};
            *(LAS u32x4*)(VT + img_off(2 * kp + 1, 2 * th)) = (u32x4){v1p[0], v1p[1], v1p[2], v1p[3]}; *(LAS u32x4*)(VT + img_off(2 * kp + 1, 2 * th + 1)) = (u32x4){v1p[4], v1p[5], v1p[6], v1p[7]};
            if (th == 0) { *(LAS f32x2*)(EV + 2 * kp) = (f32x2){__expf(r00), __expf(r01)}; *(LAS f32x2*)(EV + 128 + 2 * kp) = (f32x2){__expf(m0), __expf(m1)}; }
        }
        __syncthreads();
        f32x16 oa, ob;
#pragma unroll
        for (int i = 0; i < 16; ++i) { oa[i] = 0.f; ob[i] = 0.f; }
        for (int j = 0; j <= tb; ++j) {
            const bool same = (j >> 1) == subt;
            const LAS unsigned char* Kt = same ? KD : KB; const LAS unsigned char* Qt = same ? QD : QB; const int qrow = same ? 32 * tb : 32 * tb - 64;
            f32x16 X;
#pragma unroll
            for (int i = 0; i < 16; ++i) X[i] = 0.f;
#pragma unroll
            for (int ks = 0; ks < 8; ++ks) X = MFMA32(ldfrag(Kt, 32 * j + r, 2 * ks + hh), ldfrag(Qt, qrow + r, 2 * ks + hh), X);
            if (j == tb) {
#pragma unroll
                for (int i = 0; i < 16; ++i) { const int sl = (i & 3) + 8 * (i >> 2) + 4 * hh; X[i] = (sl > r) ? 0.f : X[i]; }
            }
#pragma unroll
            for (int sp = 0; sp < 2; ++sp) {
                const u32x4 xp = (u32x4){pkbf(X[8 * sp], X[8 * sp + 1]), pkbf(X[8 * sp + 2], X[8 * sp + 3]), pkbf(X[8 * sp + 4], X[8 * sp + 5]), pkbf(X[8 * sp + 6], X[8 * sp + 7])};
                const bf16x8 xf = __builtin_bit_cast(bf16x8, xp);
                oa = MFMA32(ldfrag(VT, vh * 64 + r, 4 * j + 2 * sp + hh), xf, oa); ob = MFMA32(ldfrag(VT, vh * 64 + 32 + r, 4 * j + 2 * sp + hh), xf, ob);
            }
        }
        {
            const LAS unsigned char* Qt = subt ? QB : QD; const int qrow = subt ? 32 * tb - 64 : 32 * tb; const LAS float* ev = EV + subt * 128;
            const GAS bf16_t* sp0 = ST + (size_t)it * 16384 + (size_t)(vh * 64 + r) * 128 + 8 * hh;
#pragma unroll
            for (int ks = 0; ks < 8; ++ks) {
                const bf16x8 bq = ldfrag(Qt, qrow + r, 2 * ks + hh);
                const f32x4 e0 = *(const LAS f32x4*)(ev + 16 * ks + 8 * hh), e1 = *(const LAS f32x4*)(ev + 16 * ks + 8 * hh + 4);
                const u32x4 ra = *(const GAS u32x4*)(sp0 + 16 * ks), rb = *(const GAS u32x4*)(sp0 + 32 * 128 + 16 * ks);
                const u32x4 sa = (u32x4){pkbf(pg8::bf_lo(ra.x) * e0.x, pg8::bf_hi(ra.x) * e0.y), pkbf(pg8::bf_lo(ra.y) * e0.z, pg8::bf_hi(ra.y) * e0.w), pkbf(pg8::bf_lo(ra.z) * e1.x, pg8::bf_hi(ra.z) * e1.y), pkbf(pg8::bf_lo(ra.w) * e1.z, pg8::bf_hi(ra.w) * e1.w)};
                const u32x4 sb = (u32x4){pkbf(pg8::bf_lo(rb.x) * e0.x, pg8::bf_hi(rb.x) * e0.y), pkbf(pg8::bf_lo(rb.y) * e0.z, pg8::bf_hi(rb.y) * e0.w), pkbf(pg8::bf_lo(rb.z) * e1.x, pg8::bf_hi(rb.z) * e1.y), pkbf(pg8::bf_lo(rb.w) * e1.z, pg8::bf_hi(rb.w) * e1.w)};
                oa = MFMA32(__builtin_bit_cast(bf16x8, sa), bq, oa); ob = MFMA32(__builtin_bit_cast(bf16x8, sb), bq, ob);
            }
        }
        float ss = 0.f;
#pragma unroll
        for (int i = 0; i < 16; ++i) ss += oa[i] * oa[i] + ob[i] * ob[i];
        ss += __shfl_xor(ss, 32);
        if (hh == 0) NP[th * 32 + r] = ss;
        __syncthreads();
        const float rstd = __builtin_amdgcn_rsqf((ss + NP[(7 - th) * 32 + r]) * (1.0f / 128.0f) + EPS);
        GAS bf16_t* prow = P + (rowc + 32 * tb + r) * PLD + h * 128 + vh * 64 + 4 * hh;
        const GAS float* gwp = gw + vh * 64 + 4 * hh;
        if (!dry)
#pragma unroll
        for (int g = 0; g < 4; ++g) {
            const u32x2 sga = *(const GAS u32x2*)(prow + 3072 + 8 * g), sgb = *(const GAS u32x2*)(prow + 3072 + 32 + 8 * g);
            const f32x4 ga = *(const GAS f32x4*)(gwp + 8 * g), gb = *(const GAS f32x4*)(gwp + 32 + 8 * g);
            *(GAS u32x2*)(prow + 8 * g) = (u32x2){pkbf(oa[4 * g] * rstd * ga.x * pg8::bf_lo(sga.x), oa[4 * g + 1] * rstd * ga.y * pg8::bf_hi(sga.x)), pkbf(oa[4 * g + 2] * rstd * ga.z * pg8::bf_lo(sga.y), oa[4 * g + 3] * rstd * ga.w * pg8::bf_hi(sga.y))};
            *(GAS u32x2*)(prow + 32 + 8 * g) = (u32x2){pkbf(ob[4 * g] * rstd * gb.x * pg8::bf_lo(sgb.x), ob[4 * g + 1] * rstd * gb.y * pg8::bf_hi(sgb.x)), pkbf(ob[4 * g + 2] * rstd * gb.z * pg8::bf_lo(sgb.y), ob[4 * g + 3] * rstd * gb.w * pg8::bf_hi(sgb.y))};
        }
        __syncthreads();
    }
}
__device__ __forceinline__ void p_onorm(Frame& F, int L) {
    GAS bf16_t* P = (GAS bf16_t*)(F.ws + WS_P); const GAS bf16_t* O = (const GAS bf16_t*)(F.ws + WS_S); const GAS float* gw = F.in[I_GNW] + L * HV;
    const int gw_ = F.vcu * NWAVES + F.wave, NGW = F.G * NWAVES, c0 = (F.lane & 7) * 16;
    float g[16];
#pragma unroll
    for (int j = 0; j < 16; ++j) g[j] = gw[c0 + j];
    for (int m = gw_; m < T; m += NGW) {
        const u32x4 o0 = *(const GAS u32x4*)(O + (size_t)m * 1024 + F.lane * 16), o1 = *(const GAS u32x4*)(O + (size_t)m * 1024 + F.lane * 16 + 8);
        const u32x4 s0 = *(const GAS u32x4*)(P + (size_t)m * PLD + 3072 + F.lane * 16), s1 = *(const GAS u32x4*)(P + (size_t)m * PLD + 3072 + F.lane * 16 + 8);
        float v[16], sg[16];
#pragma unroll
        for (int q = 0; q < 4; ++q) { v[2 * q] = pg8::bf_lo(o0[q]); v[2 * q + 1] = pg8::bf_hi(o0[q]); v[8 + 2 * q] = pg8::bf_lo(o1[q]); v[8 + 2 * q + 1] = pg8::bf_hi(o1[q]);
            sg[2 * q] = pg8::bf_lo(s0[q]); sg[2 * q + 1] = pg8::bf_hi(s0[q]); sg[8 + 2 * q] = pg8::bf_lo(s1[q]); sg[8 + 2 * q + 1] = pg8::bf_hi(s1[q]); }
        float s = 0.f;
#pragma unroll
        for (int j = 0; j < 16; ++j) s += v[j] * v[j];
        s += __shfl_xor(s, 1); s += __shfl_xor(s, 2); s += __shfl_xor(s, 4);
        const float r = __builtin_amdgcn_rsqf(s * (1.0f / 128.0f) + EPS);
        u32x4 w0, w1;
#pragma unroll
        for (int q = 0; q < 4; ++q) { w0[q] = pk2(v[2 * q] * r * g[2 * q] * sg[2 * q], v[2 * q + 1] * r * g[2 * q + 1] * sg[2 * q + 1]);
            w1[q] = pk2(v[8 + 2 * q] * r * g[8 + 2 * q] * sg[8 + 2 * q], v[8 + 2 * q + 1] * r * g[8 + 2 * q + 1] * sg[8 + 2 * q + 1]); }
        *(GAS u32x4*)(P + (size_t)m * PLD + F.lane * 16) = w0; *(GAS u32x4*)(P + (size_t)m * PLD + F.lane * 16 + 8) = w1;
    }
}
__device__ __forceinline__ void p_conv(Frame& F, int L, bool dry) {
    GAS bf16_t* P = (GAS bf16_t*)(F.ws + WS_P); const GAS float* cw = F.in[I_CONVW] + (size_t)L * 3 * D;
    const int cb = (F.tid & 127) * 8, rsub = F.tid >> 7;
    float w0[8], w1[8], w2[8];
#pragma unroll
    for (int j = 0; j < 8; ++j) { w0[j] = cw[cb + j]; w1[j] = cw[D + cb + j]; w2[j] = cw[2 * D + cb + j]; }
    const int rows_per = T / F.G;
    for (int rr = rsub; rr < rows_per; rr += 4) {
        const int m = F.vcu * rows_per + rr, t = m & (SEQ - 1);
        const u32x4 z = (u32x4){0u, 0u, 0u, 0u};
        const u32x4 v2 = *(const GAS u32x4*)(P + (size_t)m * PLD + 1024 + cb);
        const u32x4 v1 = (t >= 1) ? *(const GAS u32x4*)(P + (size_t)(m - 1) * PLD + 1024 + cb) : z;
        const u32x4 v0 = (t >= 2) ? *(const GAS u32x4*)(P + (size_t)(m - 2) * PLD + 1024 + cb) : z;
        const u32x4 c = *(const GAS u32x4*)(P + (size_t)m * PLD + 2048 + cb);
        u32x4 o;
#pragma unroll
        for (int q = 0; q < 4; ++q) {
            const float a = pg8::bf_lo(c[q]) * (w0[2 * q] * pg8::bf_lo(v0[q]) + w1[2 * q] * pg8::bf_lo(v1[q]) + w2[2 * q] * pg8::bf_lo(v2[q]));
            const float b = pg8::bf_hi(c[q]) * (w0[2 * q + 1] * pg8::bf_hi(v0[q]) + w1[2 * q + 1] * pg8::bf_hi(v1[q]) + w2[2 * q + 1] * pg8::bf_hi(v2[q]));
            o[q] = pk2(a, b); }
        if (!dry) *(GAS u32x4*)(P + (size_t)m * PLD + 2048 + cb) = o;
    }
}
__device__ __forceinline__ void p_route1(Frame& F) {
    LAS float* RW = (LAS float*)F.lds;
    LAS unsigned* CNT = (LAS unsigned*)(F.lds + 32768);
    const GAS float* nf = F.in[I_NFFN] + D; const GAS float* rw = F.in[I_RW];
    for (int i = F.tid; i < 8192; i += NWAVES * 64) RW[i] = rw[i] * nf[i >> 3];
    if (F.tid < 16) CNT[F.tid] = 0u;
    __syncthreads();
    const GAS float* ssq = (const GAS float*)(F.ws + OFF_SSQ) + (size_t)3 * T * 4;
    GAS f32x4* route = (GAS f32x4*)(F.ws + OFF_ROUTE);
    const int per = T / F.G;
    for (int i = F.wave; i < per; i += NWAVES) {
        const int m = F.vcu * per + i;
        float lg[8];
#pragma unroll
        for (int e = 0; e < 8; ++e) lg[e] = 0.f;
#pragma unroll
        for (int j = 0; j < 4; ++j) { const f32x4 v = *((const GAS f32x4*)(F.X + (size_t)m * D) + F.lane + 64 * j); const int k0 = (F.lane + 64 * j) * 4;
#pragma unroll
            for (int q = 0; q < 4; ++q) { const f32x4 r0 = *(const LAS f32x4*)(RW + (k0 + q) * 8), r1 = *(const LAS f32x4*)(RW + (k0 + q) * 8 + 4);
                lg[0] += v[q] * r0.x; lg[1] += v[q] * r0.y; lg[2] += v[q] * r0.z; lg[3] += v[q] * r0.w; lg[4] += v[q] * r1.x; lg[5] += v[q] * r1.y; lg[6] += v[q] * r1.z; lg[7] += v[q] * r1.w; } }
#pragma unroll
        for (int e = 0; e < 8; ++e) lg[e] = wave_sum(lg[e]);
        const float rstd = pg8::rstd_of(ssq, m);
        int e1 = 0; float v1 = lg[0];
#pragma unroll
        for (int e = 1; e < 8; ++e) if (lg[e] > v1) { v1 = lg[e]; e1 = e; }
        int e2 = -1; float v2 = -3.0e38f;
#pragma unroll
        for (int e = 0; e < 8; ++e) if (e != e1 && lg[e] > v2) { v2 = lg[e]; e2 = e; }
        const float g1 = 1.0f / (1.0f + __expf((v2 - v1) * rstd)), g2 = 1.0f - g1;
        if (F.lane == 0) { route[m] = (f32x4){__int_as_float(e1), __int_as_float(e2), g1, g2}; __hip_atomic_fetch_add(CNT + e1, 1u, __ATOMIC_RELAXED, __HIP_MEMORY_SCOPE_WORKGROUP); __hip_atomic_fetch_add(CNT + 8 + e2, 1u, __ATOMIC_RELAXED, __HIP_MEMORY_SCOPE_WORKGROUP); }
    }
    __syncthreads();
    if (F.tid < 16) __hip_atomic_store((GAS unsigned*)(F.ws + OFF_BLKCNT) + F.vcu * 16 + F.tid, CNT[F.tid], RLX_AGENT);
}
__device__ __forceinline__ void p_route2(Frame& F) {
    LAS unsigned* TOT = (LAS unsigned*)F.lds;
    LAS unsigned* PRE = TOT + 16;
    LAS unsigned* BASE = PRE + 16;
    LAS unsigned* PT = BASE + 16;
    LAS f32x4* RT = (LAS f32x4*)(F.lds + 8192);
    LAS float* RS = (LAS float*)(F.lds + 8192 + 4096);
    const GAS unsigned* bc = (const GAS unsigned*)(F.ws + OFF_BLKCNT);
    const GAS f32x4* route = (const GAS f32x4*)(F.ws + OFF_ROUTE); const GAS float* ssq = (const GAS float*)(F.ws + OFF_SSQ) + (size_t)3 * T * 4;
    const int per = T / F.G;
    { const int ent = F.tid & 15, ch = F.tid >> 4; unsigned tot = 0, pre = 0;
      for (int b = ch * 8; b < ch * 8 + 8 && b < F.G; ++b) { const unsigned c = __hip_atomic_load(bc + b * 16 + ent, RLX_AGENT); tot += c; if (b < F.vcu) pre += c; }
      PT[ch * 16 + ent] = tot; PT[512 + ch * 16 + ent] = pre; }
    for (int i = F.tid; i < per; i += NWAVES * 64) { const int m = F.vcu * per + i; RT[i] = route[m]; RS[i] = pg8::rstd_of(ssq, m); }
    __syncthreads();
    if (F.tid < 16) { unsigned tot = 0, pre = 0; for (int ch = 0; ch < 32; ++ch) { tot += PT[ch * 16 + F.tid]; pre += PT[512 + ch * 16 + F.tid]; } TOT[F.tid] = tot; PRE[F.tid] = pre; }
    __syncthreads();
    if (F.tid == 0) { unsigned base = 0; for (int i = 0; i < 16; ++i) { BASE[i] = base; base += (TOT[i] + 255u) & ~255u; } }
    __syncthreads();
    GAS int* tok = (GAS int*)(F.ws + OFF_TOK); GAS float* gate = (GAS float*)(F.ws + OFF_GATE); GAS float* rss = (GAS float*)(F.ws + OFF_RSS);
    if (F.tid < 16) { const int r = F.tid >> 3, e = F.tid & 7; unsigned pos = BASE[F.tid] + PRE[F.tid];
        for (int i = 0; i < per; ++i) { const f32x4 rt = RT[i]; const int ee = __float_as_int(r == 0 ? rt.x : rt.y);
            if (ee == e) { tok[pos] = F.vcu * per + i; gate[pos] = (r == 0) ? rt.z : rt.w; rss[pos] = RS[i]; ++pos; } } }
    if (blockIdx.x == 0) {
        GAS unsigned* meta = (GAS unsigned*)(F.ws + OFF_META);
        if (F.tid < 16) { const int r = F.tid >> 3; const unsigned n = TOT[F.tid], b0 = BASE[F.tid], pe = (n + 255u) & ~255u;
            int neg1 = -1; float zero = 0.f; asm volatile("" : "+v"(neg1), "+v"(zero));
#pragma nounroll
            for (unsigned s = b0 + n; s < b0 + pe; ++s) { tok[s] = neg1; gate[s] = zero; rss[s] = zero; }
            for (unsigned tl = b0 / 256; tl < (b0 + pe) / 256; ++tl) __hip_atomic_store(meta + 16 + tl, (unsigned)(F.tid & 7), RLX_AGENT); }
        if (F.tid < 2) { unsigned nt = 0; for (int e = 0; e < 8; ++e) nt += (TOT[F.tid * 8 + e] + 255u) >> 8; __hip_atomic_store(meta + F.tid, nt, RLX_AGENT); }
    }
}
__device__ __forceinline__ void p_gather(Frame& F) {
    const GAS int* tok = (const GAS int*)(F.ws + OFF_TOK); const GAS unsigned char* XB8 = F.ws + WS_XB8; GAS unsigned char* AG = F.ws + WS_AG;
    const GAS unsigned* meta = (const GAS unsigned*)(F.ws + OFF_META);
    const int nrows = (int)(__hip_atomic_load(meta, RLX_AGENT) + __hip_atomic_load(meta + 1, RLX_AGENT)) * 256;
    const int gw = F.vcu * NWAVES + F.wave, NGW = F.G * NWAVES;
    for (int s0 = gw * 4; s0 < nrows; s0 += NGW * 4) {
        int tk[4]; u32x4 v[4];
#pragma unroll
        for (int j = 0; j < 4; ++j) tk[j] = __hip_atomic_load(tok + s0 + j, RLX_AGENT);
#pragma unroll
        for (int j = 0; j < 4; ++j) v[j] = (tk[j] >= 0) ? *(const GAS u32x4*)(XB8 + (size_t)tk[j] * 1024 + F.lane * 16) : (u32x4){0u, 0u, 0u, 0u};
#pragma unroll
        for (int j = 0; j < 4; ++j) *(GAS u32x4*)(AG + (size_t)(s0 + j) * 1024 + F.lane * 16) = v[j];
    }
}
__device__ __forceinline__ void p_final(Frame& F) {
    const int gw = F.vcu * NWAVES + F.wave, NGW = F.G * NWAVES; const GAS float* fn = F.in[I_FN];
    f32x4 w[4];
#pragma unroll
    for (int j = 0; j < 4; ++j) w[j] = *((const GAS f32x4*)fn + F.lane + 64 * j);
    for (int m = gw; m < T; m += NGW) { GAS f32x4* xr = (GAS f32x4*)(F.X + (size_t)m * D) + F.lane; f32x4 v[4]; float s = 0.f;
#pragma unroll
        for (int j = 0; j < 4; ++j) { v[j] = xr[64 * j]; s += (v[j].x * v[j].x + v[j].y * v[j].y) + (v[j].z * v[j].z + v[j].w * v[j].w); }
        float r = __builtin_amdgcn_rsqf(wave_sum(s) * (1.0f / 1024.0f) + EPS);
        if (PROBE_A >= 0) { const GAS unsigned long long* st = (const GAS unsigned long long*)(F.ws + 32768); const long long tk = (long long)(st[PROBE_B < 0 ? 0 : PROBE_B] - st[PROBE_A < 0 ? 0 : PROBE_A]); r *= 1.0f + (float)((tk / PROBE_Q) * PROBE_Q) * (0.01f / PROBE_DIV); }
#pragma unroll
        for (int j = 0; j < 4; ++j) xr[64 * j] = v[j] * r * w[j]; }
}

struct Args { const GAS float* in[18]; GAS float* out; GAS unsigned char* ws; int ph_lo, ph_hi; };
__global__ void __launch_bounds__(NWAVES * 64, 2) mk_fwd(Args args) {
    extern __shared__ __attribute__((aligned(16))) unsigned char lds[];
    Frame F;
    F.lds = (LAS unsigned char*)lds; F.MISC = (volatile LAS unsigned*)(F.lds + MISC_OFF);
    F.tid = threadIdx.x; F.lane = F.tid & 63; F.wave = __builtin_amdgcn_readfirstlane(F.tid >> 6);
    F.G = gridDim.x; { const int bx = blockIdx.x; F.vcu = (F.G % 8 == 0) ? (bx % 8) * (F.G / 8) + bx / 8 : bx; }
    F.ws = args.ws; F.X = args.out;
    F.in = args.in;
    GAS unsigned* ctl = (GAS unsigned*)(F.ws + WS_CTL);
    for (int u = F.tid; u < (LDS_BYTES - LDSCTL_OFF) / 4; u += NWAVES * 64) ((LAS unsigned*)(F.lds + LDSCTL_OFF))[u] = 0u;
    __syncthreads();
    XcdBarrier bar; bar.bar = (unsigned*)(ctl + CW_BAR); bar.x = 0; bar.st = nullptr;
    if (!MK_PER_PHASE) bar = xcd_barrier_post((unsigned*)(ctl + CW_BAR), F.MISC + 8);
    const int lo = args.ph_lo, hi = args.ph_hi; int ph = 0;
#ifndef PH_MASK
#define PH_MASK 0xFFFFFFFFu
#endif
#define PH_ON(k) (((PH_MASK) >> (k)) & 1u)
#ifndef PROBE_CHEAP
#define PROBE_CHEAP 0
#endif
#ifndef PROBE_NN
#define PROBE_NN 22
#endif
#ifndef DUP_MASK
#define DUP_MASK 0u
#endif
#define DUP_ON(k) ((int)(((DUP_MASK) >> (k)) & 1u))
#define STAMP(i) do { if (PROBE_A >= 0 && blockIdx.x == 0 && threadIdx.x == 0) ((GAS unsigned long long*)(F.ws + 32768))[(i)] = wall_clock64(); } while (0)
#define PHASE_BEGIN(k) if (PH_ON(k) && ph >= lo && ph < hi) { for (int rep_ = 0; rep_ <= DUP_ON(k); ++rep_) { const bool more_ = rep_ < DUP_ON(k); STAMP(2 * ph); asm volatile("" : "+v"(F.tid), "+v"(F.lane), "+s"(F.vcu), "+s"(F.ws), "+s"(F.X)); \
    GAS bf16_t* const P = (GAS bf16_t*)(F.ws + WS_P); GAS bf16_t* const SB = (GAS bf16_t*)(F.ws + WS_S); GAS bf16_t* const XB = (GAS bf16_t*)(F.ws + WS_XB); \
    GAS bf16_t* const WNE = (GAS bf16_t*)(F.ws + WS_WNE); GAS float* const SSQ = (GAS float*)(F.ws + OFF_SSQ); const GAS float* const LBp = (const GAS float*)(F.ws + OFF_LB); \
    (void)P; (void)SB; (void)XB; (void)WNE; (void)SSQ; (void)LBp;
#define PHASE_END(last) STAMP(2 * ph + 1); if (!MK_PER_PHASE && (!(last) || more_)) xcd_barrier(bar); } } ++ph;

    PHASE_BEGIN(0) p_prologue(F); PHASE_END(false)
    if (DUP_ON(17) && !MK_PER_PHASE) { for (int i = 0; i < 20; ++i) xcd_barrier(bar); }

#pragma nounroll
    for (int L = 0; L < 2; ++L) {
        PHASE_BEGIN(1)
            pg8::Gemm g{XB, WNE + WN_INA + (size_t)L * 4096 * 1024, 1024, 1024, 0, 0}; pg8::StaticOrder S; S.init(T / 256, 16, F.G, (int)blockIdx.x);
            pg8::EpiG1a E{P, SSQ + (size_t)(2 * L) * T * 4, LBp + L * 1024}; pg8::gemm_phase(F.lds, g, S, E);
        PHASE_END(false)
#if USE_NAIVE_SCAN
        PHASE_BEGIN(2) p_scan(F); PHASE_END(false)
        PHASE_BEGIN(3) p_onorm(F, L); PHASE_END(false)
#else
        PHASE_BEGIN(2) p_r1(F); PHASE_END(false)
        PHASE_BEGIN(16) p_r2(F, more_); PHASE_END(false)
        PHASE_BEGIN(3) p_r3(F, L, more_); PHASE_END(false)
#endif
        PHASE_BEGIN(4)
            pg8::Gemm g{XB, WNE + WN_INB + (size_t)L * 5120 * 1024, 1024, 1024, 0, 0}; pg8::StaticOrder S; S.init(T / 256, 20, F.G, (int)blockIdx.x);
            pg8::EpiG1b E{P, SB, SSQ + (size_t)(2 * L) * T * 4}; pg8::gemm_phase(F.lds, g, S, E);
        PHASE_END(false)
        PHASE_BEGIN(5) p_conv(F, L, more_); PHASE_END(false)
        PHASE_BEGIN(6)
            pg8::Gemm g{P, WNE + WN_PROJ + (size_t)L * 1024 * 2048, PLD, 2048, 2048, 0}; pg8::StaticOrder S; S.init(T / 256, 4, F.G, (int)blockIdx.x);
            pg8::EpiG2 E{P, SB, (GAS bf16_t*)(F.ws + WS_MRG), more_}; pg8::gemm_phase(F.lds, g, S, E);
        PHASE_END(false)
        PHASE_BEGIN(7)
            pg8::Gemm g{(const GAS bf16_t*)(F.ws + WS_MRG), WNE + WN_OUT + (size_t)L * 1024 * 1024, 1024, 1024, 0, 0}; pg8::StaticOrder S; S.init(T / 256, 4, F.G, (int)blockIdx.x);
            pg8::EpiRes E{F.X, XB, SSQ + (size_t)(2 * L + 1) * T * 4, (LAS float*)(F.lds + RED_OFF), more_, L == 1}; pg8::gemm_phase(F.lds, g, S, E);
        PHASE_END(false)
        if (L == 0) {
            PHASE_BEGIN(8)
                pg8::Gemm g{XB, WNE + WN_D13, 1024, 1024, 0, 0}; pg8::StaticOrder S; S.init(T / 256, more_ ? PROBE_NN : 22, F.G, (int)blockIdx.x);
                pg8::EpiSwiglu<false> E{P, SSQ + (size_t)T * 4, more_ && PROBE_CHEAP}; pg8::gemm_phase(F.lds, g, S, E);
            PHASE_END(false)
            PHASE_BEGIN(9)
                pg8::Gemm g{P, WNE + WN_D2, DFF, DFF, 0, 0}; pg8::StaticOrder S; S.init(T / 256, 4, F.G, (int)blockIdx.x);
                pg8::EpiRes E{F.X, XB, SSQ + (size_t)2 * T * 4, (LAS float*)(F.lds + RED_OFF), more_, false}; pg8::gemm_phase(F.lds, g, S, E);
            PHASE_END(false)
        } else {
            PHASE_BEGIN(10) p_convert_experts(F); __syncthreads(); p_route1(F); PHASE_END(false)
            PHASE_BEGIN(11) p_route2(F); PHASE_END(false)
            PHASE_BEGIN(12) p_gather(F); PHASE_END(false)
            PHASE_BEGIN(13)
                const GAS unsigned* meta = (const GAS unsigned*)(F.ws + OFF_META);
                const int nt = (int)__builtin_amdgcn_readfirstlane(__hip_atomic_load(meta, RLX_AGENT) + __hip_atomic_load(meta + 1, RLX_AGENT));
                LAS unsigned* te = (LAS unsigned*)(F.lds + RSCR_OFF + 4096); for (int i = F.tid; i < NSTILE2; i += NWAVES * 64) te[i] = __hip_atomic_load(meta + 16 + i, RLX_AGENT); __syncthreads();
                pg8::Gemm g{(const GAS bf16_t*)(F.ws + WS_AG), (const GAS bf16_t*)(F.ws + WS_WE + WE_13), 512, 512, 0, (size_t)5632 * 512}; pg8::MoeOrder S; S.so.init(nt, 22, F.G, (int)blockIdx.x); S.tile_e = te; S.pm_off = 0;
                pg8::EpiSwiglu<true> E{(GAS bf16_t*)(F.ws + WS_H), (const GAS float*)(F.ws + OFF_RSS), false}; pg8::gemm_phase<pg8::EpiSwiglu<true>, pg8::MoeOrder, true>(F.lds, g, S, E);
            PHASE_END(false)
#pragma nounroll
            for (int r = 0; r < 2; ++r) {
                PHASE_BEGIN(14)
                    const GAS unsigned* meta = (const GAS unsigned*)(F.ws + OFF_META);
                    const int nt0 = (int)__builtin_amdgcn_readfirstlane(__hip_atomic_load(meta, RLX_AGENT)), nt1 = (int)__builtin_amdgcn_readfirstlane(__hip_atomic_load(meta + 1, RLX_AGENT));
                    LAS unsigned* te = (LAS unsigned*)(F.lds + RSCR_OFF + 4096); for (int i = F.tid; i < NSTILE2; i += NWAVES * 64) te[i] = __hip_atomic_load(meta + 16 + i, RLX_AGENT); __syncthreads();
                    pg8::Gemm g{(const GAS bf16_t*)(F.ws + WS_H), (const GAS bf16_t*)(F.ws + WS_WE + WE_2), DFF / 2, DFF / 2, 0, (size_t)1024 * (DFF / 2)}; pg8::MoeOrder S; S.so.init(r ? nt1 : nt0, 4, F.G, (int)blockIdx.x); S.tile_e = te; S.pm_off = r ? nt0 : 0;
                    pg8::EpiDown E{F.X, (const GAS int*)(F.ws + OFF_TOK), (const GAS float*)(F.ws + OFF_GATE), more_}; pg8::gemm_phase<pg8::EpiDown, pg8::MoeOrder, true>(F.lds, g, S, E);
                PHASE_END(false)
            }
        }
    }
    PHASE_BEGIN(15) p_final(F); PHASE_END(true)
}
constexpr int N_PHASES = 1 + 7 + 2 + 7 + 3 + 3 + 1 + (USE_NAIVE_SCAN ? 0 : 2);

extern "C" void kernel_launch(void* const* d_in, const int* in_sizes, int n_in, void* d_out, int out_size, void* d_ws, size_t ws_size, hipStream_t stream) {
    static int grid = 0;
    if (grid == 0) {
        if (n_in != 18 || in_sizes[0] != T * D || out_size != T * D || ws_size < WS_END) { fprintf(stderr, "kernel_launch: unexpected shapes / workspace (n_in %d, ws %zu, need %zu); nothing launched\n", n_in, ws_size, (size_t)WS_END); grid = -1; return; }
        int dev = 0, cus = 0, per_cu = 0;
        if (hipGetDevice(&dev) != hipSuccess || hipDeviceGetAttribute(&cus, hipDeviceAttributeMultiprocessorCount, dev) != hipSuccess) { grid = -1; return; }
        if (hipFuncSetAttribute((const void*)mk_fwd, hipFuncAttributeMaxDynamicSharedMemorySize, LDS_BYTES) != hipSuccess) { fprintf(stderr, "kernel_launch: hipFuncSetAttribute failed\n"); grid = -1; return; }
        if (hipOccupancyMaxActiveBlocksPerMultiprocessor(&per_cu, (const void*)mk_fwd, NWAVES * 64, LDS_BYTES) != hipSuccess || per_cu < 1) { fprintf(stderr, "kernel_launch: occupancy query says %d\n", per_cu); }
        (void)hipGetLastError();
        grid = cus;
    }
    if (grid < 0) return;
    if (hipMemsetAsync((char*)d_ws + WS_CTL, 0, ZERO_BYTES, stream) != hipSuccess) return;
    Args a{};
    for (int i = 0; i < 18; ++i) a.in[i] = (const GAS float*)d_in[i];
    a.out = (GAS float*)d_out; a.ws = (GAS unsigned char*)d_ws;
#if MK_PER_PHASE
    for (int p = 0; p < N_PHASES; ++p) { a.ph_lo = p; a.ph_hi = p + 1; hipLaunchKernelGGL(mk_fwd, dim3(grid), dim3(NWAVES * 64), LDS_BYTES, stream, a); }
#else
    a.ph_lo = 0; a.ph_hi = N_PHASES; hipLaunchKernelGGL(mk_fwd, dim3(grid), dim3(NWAVES * 64), LDS_BYTES, stream, a);
#endif
}
```
